# Optimizing an MI355X kernel written in HIP

```python
import jax, jax.numpy as jnp
from jax import lax
import numpy as np

D_MODEL = 1024
BATCH = 16
SEQ = 2048
DEPTH = 2

N_A_LAYERS = DEPTH // 2
N_B_LAYERS = DEPTH - N_A_LAYERS
LRU_WIDTH = D_MODEL
LRU_HEADS = 8
LRU_BLOCK = LRU_WIDTH // LRU_HEADS
CONV_WIDTH = 4
LRU_C = 8.0
ATTN_HEADS = 16
ATTN_HEAD_DIM = 64
ATTN_WIDTH = ATTN_HEADS * ATTN_HEAD_DIM
Q_BLOCK = 128
PEER_HEADS = 8
PEER_NKEYS = 128
PEER_EXPERTS = PEER_NKEYS * PEER_NKEYS
PEER_TOPK = 16
PEER_QDIM = 256
PEER_HALF = PEER_QDIM // 2
PEER_CHUNK = 128
PLE_DIM = 256
EPS = 1e-6

kernel_name = 'yoco_rglru_stickbreak_peer'


def rms_norm(x, g):
    xf = x.astype(jnp.float32)
    y = xf * lax.rsqrt(jnp.mean(xf * xf, axis=-1, keepdims=True) + EPS)
    return (y * g.astype(jnp.float32)).astype(x.dtype)


def rglru_block(h, w_in, conv_w, conv_b, w_r, w_i, b_r, b_i, lam, w_out):
    B, S, _ = h.shape
    proj = h @ w_in
    y_branch, x_branch = jnp.split(proj, 2, axis=-1)
    xc = lax.conv_general_dilated(x_branch, conv_w[:, None, :], window_strides=(1,),
                                  padding=((CONV_WIDTH - 1, 0),),
                                  dimension_numbers=('NWC', 'WIO', 'NWC'),
                                  feature_group_count=LRU_WIDTH) + conv_b
    xb = xc.reshape(B, S, LRU_HEADS, LRU_BLOCK)
    r = jax.nn.sigmoid(jnp.einsum('bshi,hij->bshj', xb, w_r).reshape(B, S, LRU_WIDTH).astype(jnp.float32)
                       + b_r.astype(jnp.float32))
    ig = jax.nn.sigmoid(jnp.einsum('bshi,hij->bshj', xb, w_i).reshape(B, S, LRU_WIDTH).astype(jnp.float32)
                        + b_i.astype(jnp.float32))
    log_a = -LRU_C * r * jax.nn.softplus(-lam.astype(jnp.float32))
    a = jnp.exp(log_a)
    u = jnp.sqrt(-jnp.expm1(2.0 * log_a)) * ig * xc.astype(jnp.float32)

    def combine(left, right):
        a1, b1 = left
        a2, b2 = right
        return a1 * a2, a2 * b1 + b2

    _, hseq = lax.associative_scan(combine, (a, u), axis=1)
    gated = (jax.nn.gelu(y_branch.astype(jnp.float32)) * hseq).astype(h.dtype)
    return gated @ w_out


def stick_breaking_attention(q, k, v):
    S = q.shape[1]
    scale = ATTN_HEAD_DIM ** -0.5
    outs = []
    for blk in range(S // Q_BLOCK):
        q0 = blk * Q_BLOCK
        end = q0 + Q_BLOCK
        qb = q[:, q0:end].astype(jnp.float32)
        kb = k[:, :end].astype(jnp.float32)
        z = jnp.einsum('bqhd,bkhd->bhqk', qb, kb) * scale
        t_pos = q0 + jnp.arange(Q_BLOCK)[:, None]
        s_pos = jnp.arange(end)[None, :]
        causal = s_pos < t_pos
        lbeta = jax.nn.log_sigmoid(z)
        l1m = jnp.where(causal, lbeta - z, 0.0)
        rc = lax.cumsum(l1m, axis=3, reverse=True)
        A = jnp.where(causal, jnp.exp(lbeta + rc - l1m), 0.0)
        outs.append(jnp.einsum('bhqk,bkhd->bqhd', A, v[:, :end].astype(jnp.float32)))
    return jnp.concatenate(outs, axis=1).astype(v.dtype)


def peer_ffn(h, w_q, sub_keys, u_tab, v_tab):
    B, S, D = h.shape
    T = B * S
    xt = h.reshape(T, D)
    q = (xt @ w_q).reshape(T, PEER_HEADS, 2, PEER_HALF).astype(jnp.float32)
    s = jnp.einsum('thpd,hpnd->thpn', q, sub_keys.astype(jnp.float32))
    sv, si = lax.top_k(s, PEER_TOPK)
    cand = sv[:, :, 0, :, None] + sv[:, :, 1, None, :]
    cv, ci = lax.top_k(cand.reshape(T, PEER_HEADS, PEER_TOPK * PEER_TOPK), PEER_TOPK)
    i1 = jnp.take_along_axis(si[:, :, 0], ci // PEER_TOPK, axis=-1)
    i2 = jnp.take_along_axis(si[:, :, 1], ci % PEER_TOPK, axis=-1)
    eidx = (i1 * PEER_NKEYS + i2).reshape(T, PEER_HEADS * PEER_TOPK)
    gates = jax.nn.softmax(cv, axis=-1).reshape(T, PEER_HEADS * PEER_TOPK)
    n_chunks = T // PEER_CHUNK

    def chunk_fn(args):
        xc, ic, gc = args
        uc = jnp.take(u_tab, ic, axis=0)
        vc = jnp.take(v_tab, ic, axis=0)
        act = jax.nn.gelu(jnp.einsum('cd,ckd->ck', xc, uc).astype(jnp.float32))
        return jnp.einsum('ck,ckd->cd', (gc * act).astype(vc.dtype), vc)

    out = lax.map(chunk_fn, (xt.reshape(n_chunks, PEER_CHUNK, D),
                             eidx.reshape(n_chunks, PEER_CHUNK, PEER_HEADS * PEER_TOPK),
                             gates.reshape(n_chunks, PEER_CHUNK, PEER_HEADS * PEER_TOPK)))
    return out.reshape(B, S, D).astype(h.dtype)


def per_layer_embed(h, p_i, g, w_gate, w_proj):
    gate = jax.nn.sigmoid((rms_norm(h, g) @ w_gate).astype(jnp.float32))
    return h + (gate * (p_i @ w_proj).astype(jnp.float32)).astype(h.dtype)


def setup_inputs(seed: int = 0) -> dict:
    key = jax.random.key(seed)
    ks = jax.random.split(key, 28)
    nrm = jax.random.normal
    f32 = jnp.float32
    a8 = jax.random.uniform(ks[9], (N_A_LAYERS, LRU_WIDTH), f32, 0.9, 0.999)
    a0 = a8 ** (1.0 / LRU_C)
    return {
        'x': nrm(ks[0], (BATCH, SEQ, D_MODEL), f32),
        'p': nrm(ks[1], (DEPTH, BATCH, SEQ, PLE_DIM), f32),
        'norm_mix': 1.0 + 0.02 * nrm(ks[2], (DEPTH, D_MODEL), f32),
        'a_w_in': nrm(ks[3], (N_A_LAYERS, D_MODEL, 2 * LRU_WIDTH), f32) * D_MODEL ** -0.5,
        'a_conv_w': nrm(ks[4], (N_A_LAYERS, CONV_WIDTH, LRU_WIDTH), f32) * CONV_WIDTH ** -0.5,
        'a_conv_b': 0.02 * nrm(ks[5], (N_A_LAYERS, LRU_WIDTH), f32),
        'a_w_r': nrm(ks[6], (N_A_LAYERS, LRU_HEADS, LRU_BLOCK, LRU_BLOCK), f32) * LRU_BLOCK ** -0.5,
        'a_w_i': nrm(ks[7], (N_A_LAYERS, LRU_HEADS, LRU_BLOCK, LRU_BLOCK), f32) * LRU_BLOCK ** -0.5,
        'a_b_r': 0.02 * nrm(ks[8], (N_A_LAYERS, LRU_WIDTH), f32),
        'a_b_i': 0.02 * nrm(ks[10], (N_A_LAYERS, LRU_WIDTH), f32),
        'a_lambda': jnp.log(a0) - jnp.log1p(-a0),
        'a_w_out': nrm(ks[11], (N_A_LAYERS, LRU_WIDTH, D_MODEL), f32) * LRU_WIDTH ** -0.5,
        'kv_norm': 1.0 + 0.02 * nrm(ks[12], (D_MODEL,), f32),
        'w_kv': nrm(ks[13], (D_MODEL, 2 * ATTN_WIDTH), f32) * D_MODEL ** -0.5,
        'b_w_q': nrm(ks[14], (N_B_LAYERS, D_MODEL, ATTN_WIDTH), f32) * D_MODEL ** -0.5,
        'b_w_o': nrm(ks[15], (N_B_LAYERS, ATTN_WIDTH, D_MODEL), f32) * ATTN_WIDTH ** -0.5,
        'norm_ffn': 1.0 + 0.02 * nrm(ks[16], (DEPTH, D_MODEL), f32),
        'peer_w_q': nrm(ks[17], (DEPTH, D_MODEL, PEER_HEADS * PEER_QDIM), f32) * D_MODEL ** -0.5,
        'peer_sub_keys': nrm(ks[18], (DEPTH, PEER_HEADS, 2, PEER_NKEYS, PEER_HALF), f32) * PEER_HALF ** -0.5,
        'peer_u': nrm(ks[19], (DEPTH, PEER_EXPERTS, D_MODEL), f32) * D_MODEL ** -0.5,
        'peer_v': nrm(ks[20], (DEPTH, PEER_EXPERTS, D_MODEL), f32) * (PEER_HEADS * PEER_TOPK) ** -0.5,
        'norm_ple': 1.0 + 0.02 * nrm(ks[21], (DEPTH, D_MODEL), f32),
        'ple_w_gate': nrm(ks[22], (DEPTH, D_MODEL, D_MODEL), f32) * D_MODEL ** -0.5,
        'ple_w_proj': nrm(ks[23], (DEPTH, PLE_DIM, D_MODEL), f32) * PLE_DIM ** -0.5,
        'final_norm': 1.0 + 0.02 * nrm(ks[24], (D_MODEL,), f32),
    }


def reference(x, p, norm_mix, a_w_in, a_conv_w, a_conv_b, a_w_r, a_w_i, a_b_r, a_b_i, a_lambda,
              a_w_out, kv_norm, w_kv, b_w_q, b_w_o, norm_ffn, peer_w_q, peer_sub_keys, peer_u,
              peer_v, norm_ple, ple_w_gate, ple_w_proj, final_norm):
    B, S, _ = x.shape
    h = x
    k_shared = None
    v_shared = None
    for i in range(DEPTH):
        hn = rms_norm(h, norm_mix[i])
        if i < N_A_LAYERS:
            j = i
            h = h + rglru_block(hn, a_w_in[j], a_conv_w[j], a_conv_b[j], a_w_r[j], a_w_i[j],
                                a_b_r[j], a_b_i[j], a_lambda[j], a_w_out[j])
        else:
            j = i - N_A_LAYERS
            if i == N_A_LAYERS:
                kvp = rms_norm(h, kv_norm) @ w_kv
                k_flat, v_flat = jnp.split(kvp, 2, axis=-1)
                k_shared = k_flat.reshape(B, S, ATTN_HEADS, ATTN_HEAD_DIM)
                v_shared = v_flat.reshape(B, S, ATTN_HEADS, ATTN_HEAD_DIM)
            q = (hn @ b_w_q[j]).reshape(B, S, ATTN_HEADS, ATTN_HEAD_DIM)
            o = stick_breaking_attention(q, k_shared, v_shared).reshape(B, S, ATTN_WIDTH)
            h = h + o @ b_w_o[j]
        h = h + peer_ffn(rms_norm(h, norm_ffn[i]), peer_w_q[i], peer_sub_keys[i], peer_u[i], peer_v[i])
        h = per_layer_embed(h, p[i], norm_ple[i], ple_w_gate[i], ple_w_proj[i])
    return rms_norm(h, final_norm)
```

```cpp
#include <hip/hip_runtime.h>
#include <hip/hip_cooperative_groups.h>
#include <cstdio>
#include <cstdint>
namespace cg = cooperative_groups;

#ifndef MEGA
#define MEGA 1
#endif

#define DI __device__ __forceinline__
typedef unsigned short ushort_t;
typedef short bf16x8 __attribute__((ext_vector_type(8)));
typedef float f32x16 __attribute__((ext_vector_type(16)));
typedef float f32x2_t __attribute__((ext_vector_type(2)));
typedef __bf16 bf16x2_t __attribute__((ext_vector_type(2)));
typedef float f32x2 __attribute__((ext_vector_type(2)));

constexpr int T_ = 32768, D_ = 1024, S_ = 2048;
constexpr int NTHR = 256;
constexpr int SMEM_BYTES = 73728 + 2048;
constexpr int XTRA_OFF = 73728;

struct Params {
  const float *x, *p, *norm_mix, *a_w_in, *a_conv_w, *a_conv_b, *a_w_r, *a_w_i, *a_b_r, *a_b_i, *a_lambda, *a_w_out,
      *kv_norm, *w_kv, *b_w_q, *b_w_o, *norm_ffn, *peer_w_q, *peer_sub_keys, *peer_u, *peer_v, *norm_ple, *ple_w_gate,
      *ple_w_proj, *final_norm;
  float* h;
  ushort_t *Wt_in, *Wt_out, *Wt_kvq, *Wt_o, *Wt_pq, *Wt_gate, *Wt_proj, *Wt_r, *Wt_i, *SK;
  unsigned char *Ub8, *Vb8; ushort_t *pb, *hb0, *hb1, *bufA, *bufB, *bufC, *eidx;
  float *gw, *ssA, *ssB;
  unsigned* bar;
};

DI unsigned pk2(float lo, float hi) { f32x2_t v = {lo, hi}; bf16x2_t b = __builtin_convertvector(v, bf16x2_t); return __builtin_bit_cast(unsigned, b); }
DI ushort_t f2bf(float x) { return (ushort_t)(pk2(x, 0.f) & 0xffffu); }
DI float bf_lo(unsigned u) { return __uint_as_float(u << 16); }
DI float bf_hi(unsigned u) { return __uint_as_float(u & 0xffff0000u); }
DI float bf2f(ushort_t u) { return __uint_as_float(((unsigned)u) << 16); }
DI float sigmoidf_(float x) { return __builtin_amdgcn_rcpf(1.f + __expf(-x)); }
DI float gelu_tanh(float x) { float u = 1.5957691216057308f * (x + 0.044715f * x * x * x); return x * __builtin_amdgcn_rcpf(1.f + __expf(-u)); }
DI f32x16 mfma32(bf16x8 a, bf16x8 b, f32x16 c) { return __builtin_amdgcn_mfma_f32_32x32x16_bf16(a, b, c, 0, 0, 0); }
DI f32x16 zero16() { f32x16 z; for (int i = 0; i < 16; ++i) z[i] = 0.f; return z; }
DI int otid() { int t = threadIdx.x; asm volatile("" : "+v"(t)); return t; }
DI int obid() { int b = blockIdx.x; asm volatile("" : "+s"(b)); return b; }
DI float dpp_x1(float x) { return __int_as_float(__builtin_amdgcn_update_dpp(0, __float_as_int(x), 0xB1, 0xF, 0xF, false)); }
DI float dpp_x2(float x) { return __int_as_float(__builtin_amdgcn_update_dpp(0, __float_as_int(x), 0x4E, 0xF, 0xF, false)); }
DI float dpp_x4(float x) {
  int t = __builtin_amdgcn_update_dpp(0, __float_as_int(x), 0x104, 0xF, 0x5, false);
  t = __builtin_amdgcn_update_dpp(t, __float_as_int(x), 0x114, 0xF, 0xA, false);
  return __int_as_float(t);
}
DI float dpp_x8(float x) { return __int_as_float(__builtin_amdgcn_update_dpp(0, __float_as_int(x), 0x128, 0xF, 0xF, false)); }
DI float swap_add32(float a, float b) { const auto r = __builtin_amdgcn_permlane32_swap(__float_as_uint(a), __float_as_uint(b), false, false); return __uint_as_float(r[0]) + __uint_as_float(r[1]); }
DI float swap_add16(float a, float b) { const auto r = __builtin_amdgcn_permlane16_swap(__float_as_uint(a), __float_as_uint(b), false, false); return __uint_as_float(r[0]) + __uint_as_float(r[1]); }
DI float plx32(float x, bool upper) { const auto r = __builtin_amdgcn_permlane32_swap(__float_as_uint(x), __float_as_uint(x), false, false); return __uint_as_float(upper ? r[0] : r[1]); }
DI float plx16(float x, bool odd) { const auto r = __builtin_amdgcn_permlane16_swap(__float_as_uint(x), __float_as_uint(x), false, false); return __uint_as_float(odd ? r[0] : r[1]); }
DI int crow(int reg, int h) { return (reg & 3) + 8 * (reg >> 2) + 4 * h; }

DI void tconv(const float* __restrict__ W, const float* __restrict__ g, ushort_t* __restrict__ Wt, int K, int N, int nb,
              int& base, char* smem) {
  float* tile = (float*)smem;
  const int tid = otid(), G = gridDim.x;
  const int tk = K / 64, tn = N / 64, count = nb * tk * tn;
  int start = (obid() - (base % G) + G) % G;
  for (int t = start; t < count; t += G) {
    const int b = t / (tk * tn), rem = t % (tk * tn), kt = rem / tn, nt = rem % tn;
    const float* src = W + (size_t)b * K * N + (size_t)(kt * 64) * N + nt * 64;
    __syncthreads();
    {
      const int ty = tid >> 4, tx = tid & 15;
#pragma unroll
      for (int i = 0; i < 4; ++i) {
        const int kr = ty + 16 * i;
        float4 v = *(const float4*)(src + (size_t)kr * N + tx * 4);
        const float gs = g ? g[kt * 64 + kr] : 1.f;
        tile[kr * 65 + tx * 4 + 0] = v.x * gs; tile[kr * 65 + tx * 4 + 1] = v.y * gs;
        tile[kr * 65 + tx * 4 + 2] = v.z * gs; tile[kr * 65 + tx * 4 + 3] = v.w * gs;
      }
    }
    __syncthreads();
    {
      const int n = tid >> 2, kc = tid & 3;
      unsigned o[8];
#pragma unroll
      for (int i = 0; i < 8; ++i) o[i] = pk2(tile[(kc * 16 + 2 * i) * 65 + n], tile[(kc * 16 + 2 * i + 1) * 65 + n]);
      ushort_t* dst = Wt + (size_t)b * K * N + (size_t)(nt * 64 + n) * K + kt * 64 + kc * 16;
      *(uint4*)dst = make_uint4(o[0], o[1], o[2], o[3]);
      *(uint4*)(dst + 8) = make_uint4(o[4], o[5], o[6], o[7]);
    }
  }
  base += count;
}

DI void econv(const float* __restrict__ src, const float* __restrict__ g, ushort_t* __restrict__ dst, size_t n8) {
  const size_t stride = (size_t)gridDim.x * NTHR;
  for (size_t i = (size_t)obid() * NTHR + otid(); i < n8; i += stride) {
    float4 a = *(const float4*)(src + i * 8), b = *(const float4*)(src + i * 8 + 4);
    if (g) {
      const int c = (int)((i * 8) & 1023);
      float4 ga = *(const float4*)(g + c), gb = *(const float4*)(g + c + 4);
      a.x *= ga.x; a.y *= ga.y; a.z *= ga.z; a.w *= ga.w; b.x *= gb.x; b.y *= gb.y; b.z *= gb.z; b.w *= gb.w;
    }
    *(uint4*)(dst + i * 8) = make_uint4(pk2(a.x, a.y), pk2(a.z, a.w), pk2(b.x, b.y), pk2(b.z, b.w));
  }
}

constexpr float U_SCALE = 128.f, V_SCALE = 32.f;
DI void econv8(const float* __restrict__ src, const float* __restrict__ g, unsigned char* __restrict__ dst, size_t n16, float scale) {
  const size_t stride = (size_t)gridDim.x * NTHR;
  for (size_t i = (size_t)obid() * NTHR + otid(); i < n16; i += stride) {
    unsigned o[4];
#pragma unroll
    for (int q = 0; q < 4; ++q) {
      float4 a = *(const float4*)(src + i * 16 + q * 4);
      if (g) { const float4 ga = *(const float4*)(g + ((i * 16 + q * 4) & 1023)); a.x *= ga.x; a.y *= ga.y; a.z *= ga.z; a.w *= ga.w; }
      int v = 0;
      v = __builtin_amdgcn_cvt_pk_fp8_f32(a.x * scale, a.y * scale, v, false);
      v = __builtin_amdgcn_cvt_pk_fp8_f32(a.z * scale, a.w * scale, v, true);
      o[q] = (unsigned)v;
    }
    *(uint4*)(dst + i * 16) = make_uint4(o[0], o[1], o[2], o[3]);
  }
}

DI void conv_tables(const Params& P, int layer) {
  econv8(P.peer_u + (size_t)layer * 16384 * 1024, P.norm_ffn + layer * 1024, P.Ub8 + (size_t)layer * 16384 * 1024, (size_t)16384 * 1024 / 16, U_SCALE);
  econv8(P.peer_v + (size_t)layer * 16384 * 1024, nullptr, P.Vb8 + (size_t)layer * 16384 * 1024, (size_t)16384 * 1024 / 16, V_SCALE);
}

DI void phase_prep(const Params& P, char* smem) {
  int base = 0;
  tconv(P.a_w_in, P.norm_mix, P.Wt_in, 1024, 2048, 1, base, smem);
  tconv(P.a_w_r, nullptr, P.Wt_r, 128, 128, 8, base, smem);
  tconv(P.a_w_i, nullptr, P.Wt_i, 128, 128, 8, base, smem);
  tconv(P.a_w_out, nullptr, P.Wt_out, 1024, 1024, 1, base, smem);
  tconv(P.w_kv, P.kv_norm, P.Wt_kvq, 1024, 2048, 1, base, smem);
  tconv(P.b_w_q, P.norm_mix + 1024, P.Wt_kvq + (size_t)2048 * 1024, 1024, 1024, 1, base, smem);
  tconv(P.b_w_o, nullptr, P.Wt_o, 1024, 1024, 1, base, smem);
  for (int l = 0; l < 2; ++l) {
    tconv(P.peer_w_q + (size_t)l * 1024 * 2048, P.norm_ffn + l * 1024, P.Wt_pq + (size_t)l * 2048 * 1024, 1024, 2048, 1, base, smem);
    tconv(P.ple_w_gate + (size_t)l * 1024 * 1024, P.norm_ple + l * 1024, P.Wt_gate + (size_t)l * 1024 * 1024, 1024, 1024, 1, base, smem);
    tconv(P.ple_w_proj + (size_t)l * 256 * 1024, nullptr, P.Wt_proj + (size_t)l * 256 * 1024, 256, 1024, 1, base, smem);
  }
  econv(P.peer_sub_keys, nullptr, P.SK, (size_t)2 * 8 * 2 * 128 * 128 / 8);
  conv_tables(P, 0);
  conv_tables(P, 1);
  econv(P.p, nullptr, P.pb, (size_t)2 * T_ * 256 / 8);
  {
    const size_t n8 = (size_t)T_ * 1024 / 8, stride = (size_t)gridDim.x * NTHR;
    for (size_t i = (size_t)obid() * NTHR + otid(); i < n8; i += stride) {
      float4 a = *(const float4*)(P.x + i * 8), b = *(const float4*)(P.x + i * 8 + 4);
      *(uint4*)(P.hb0 + i * 8) = make_uint4(pk2(a.x, a.y), pk2(a.z, a.w), pk2(b.x, b.y), pk2(b.z, b.w));
      float s = a.x * a.x + a.y * a.y + a.z * a.z + a.w * a.w + b.x * b.x + b.y * b.y + b.z * b.z + b.w * b.w;
      s += dpp_x1(s); s += dpp_x2(s); s += dpp_x4(s); s += dpp_x8(s);
      if ((otid() & 15) == 0) P.ssA[i >> 4] = s;
    }
  }
}

constexpr int GEMM_BUF = 2 * 128 * 128;
constexpr int GEMM_SMEM = 2 * GEMM_BUF;
DI void glds16(const void* gsrc, unsigned lds_dst) {
  unsigned keep;
  asm volatile("s_mov_b32 %0, m0\n\ts_mov_b32 m0, %2\n\ts_nop 0\n\tglobal_load_lds_dwordx4 %1, off\n\ts_mov_b32 m0, %0"
               : "=&s"(keep) : "v"(gsrc), "s"(lds_dst) : "memory");
}
DI void gemm_mainloop(const ushort_t* __restrict__ A, int lda, const ushort_t* __restrict__ Bt, int ldb, int K,
                      f32x16 (&acc)[2][2], char* smem) {
  const int tid = otid(), lane = tid & 63, w = tid >> 6, wm = w >> 1, wn = w & 1, r = lane & 31, h = lane >> 5;
  const unsigned lds0 = (unsigned)(size_t)smem;
  const int drow = w * 32 + (lane >> 3);
  const ushort_t* ga[4]; const ushort_t* gb[4];
#pragma unroll
  for (int q = 0; q < 4; ++q) {
    const int row = drow + q * 8;
    const int kc = (lane & 7) ^ ((row >> 1) & 7);
    ga[q] = A + (size_t)row * lda + kc * 8;
    gb[q] = Bt + (size_t)row * ldb + kc * 8;
  }
  const unsigned dstw = (unsigned)__builtin_amdgcn_readfirstlane((int)(lds0 + (unsigned)(w * 32) * 128u));
#define G_DMA(buf, koff) { _Pragma("unroll") for (int q = 0; q < 4; ++q) { \
      glds16(ga[q] + (koff), dstw + (unsigned)((buf) * GEMM_BUF + q * 1024)); \
      glds16(gb[q] + (koff), dstw + (unsigned)((buf) * GEMM_BUF + 16384 + q * 1024)); } }
  unsigned offA[2][4], offB[2][4];
#pragma unroll
  for (int i = 0; i < 2; ++i)
#pragma unroll
    for (int kk = 0; kk < 4; ++kk) {
      const int ra_ = wm * 64 + i * 32 + r, rb_ = wn * 64 + i * 32 + r, kc = kk * 2 + h;
      offA[i][kk] = (unsigned)(ra_ * 128 + ((kc ^ ((ra_ >> 1) & 7)) * 16));
      offB[i][kk] = (unsigned)(16384 + rb_ * 128 + ((kc ^ ((rb_ >> 1) & 7)) * 16));
    }
  const int nk = K >> 6;
  __syncthreads();
  G_DMA(0, 0);
  asm volatile("s_waitcnt vmcnt(0)" ::: "memory");
  __syncthreads();
  for (int it = 0; it < nk; ++it) {
    const int buf = it & 1;
    if (it + 1 < nk) G_DMA(buf ^ 1, (it + 1) * 64);
    const char* st = smem + buf * GEMM_BUF;
#pragma unroll
    for (int kk = 0; kk < 4; ++kk) {
      const bf16x8 a0 = *(const bf16x8*)(st + offA[0][kk]);
      const bf16x8 a1 = *(const bf16x8*)(st + offA[1][kk]);
      const bf16x8 b0 = *(const bf16x8*)(st + offB[0][kk]);
      const bf16x8 b1 = *(const bf16x8*)(st + offB[1][kk]);
      acc[0][0] = mfma32(a0, b0, acc[0][0]); acc[0][1] = mfma32(a0, b1, acc[0][1]);
      acc[1][0] = mfma32(a1, b0, acc[1][0]); acc[1][1] = mfma32(a1, b1, acc[1][1]);
    }
    asm volatile("s_waitcnt vmcnt(0)" ::: "memory");
    __syncthreads();
  }
#undef G_DMA
}

constexpr int WST = 24576;
DI void gemm_mainloop_w(const ushort_t* __restrict__ A, int lda, const ushort_t* __restrict__ Bt, int ldb, int K,
                        f32x16 (&acc)[2][4], char* smem) {
  const int tid = otid(), lane = tid & 63, w = tid >> 6, wm = w >> 1, wn = w & 1, r = lane & 31, h = lane >> 5;
  const unsigned lds0 = (unsigned)(size_t)smem;
  const ushort_t* ga[2]; const ushort_t* gb[4];
#pragma unroll
  for (int q = 0; q < 2; ++q) {
    const int row = (2 * w + q) * 16 + (lane >> 2);
    ga[q] = A + (size_t)row * lda + (((lane & 3) ^ ((row >> 2) & 3)) * 8);
  }
#pragma unroll
  for (int q = 0; q < 4; ++q) {
    const int row = (4 * w + q) * 16 + (lane >> 2);
    gb[q] = Bt + (size_t)row * ldb + (((lane & 3) ^ ((row >> 2) & 3)) * 8);
  }
  const unsigned dsta = (unsigned)__builtin_amdgcn_readfirstlane((int)(lds0 + (unsigned)(2 * w) * 1024u));
  const unsigned dstb = (unsigned)__builtin_amdgcn_readfirstlane((int)(lds0 + 8192u + (unsigned)(4 * w) * 1024u));
#define GW_DMA(stg, koff) { _Pragma("unroll") for (int q = 0; q < 2; ++q) glds16(ga[q] + (koff), dsta + (unsigned)((stg) * WST + q * 1024)); \
    _Pragma("unroll") for (int q = 0; q < 4; ++q) glds16(gb[q] + (koff), dstb + (unsigned)((stg) * WST + q * 1024)); }
  unsigned offA[2][2], offB[4][2];
#pragma unroll
  for (int kk = 0; kk < 2; ++kk) {
    const int kc = kk * 2 + h;
#pragma unroll
    for (int i = 0; i < 2; ++i) { const int ra_ = wm * 64 + i * 32 + r; offA[i][kk] = (unsigned)(ra_ * 64 + ((kc ^ ((ra_ >> 2) & 3)) * 16)); }
#pragma unroll
    for (int j = 0; j < 4; ++j) { const int rb_ = wn * 128 + j * 32 + r; offB[j][kk] = (unsigned)(8192 + rb_ * 64 + ((kc ^ ((rb_ >> 2) & 3)) * 16)); }
  }
  const int nk = K >> 5;
  __syncthreads();
  GW_DMA(0, 0);
  asm volatile("s_waitcnt vmcnt(0)" ::: "memory");
  __syncthreads();
  for (int it = 0; it < nk; ++it) {
    const int buf = it & 1;
    if (it + 1 < nk) GW_DMA(buf ^ 1, (it + 1) * 32);
    const char* st = smem + buf * WST;
#pragma unroll
    for (int kk = 0; kk < 2; ++kk) {
      const bf16x8 a0 = *(const bf16x8*)(st + offA[0][kk]);
      const bf16x8 a1 = *(const bf16x8*)(st + offA[1][kk]);
#pragma unroll
      for (int j = 0; j < 4; ++j) {
        const bf16x8 bj = *(const bf16x8*)(st + offB[j][kk]);
        acc[0][j] = mfma32(a0, bj, acc[0][j]);
        acc[1][j] = mfma32(a1, bj, acc[1][j]);
      }
    }
    asm volatile("s_waitcnt vmcnt(0)" ::: "memory");
    __syncthreads();
  }
#undef GW_DMA
}

DI void tile_rowsumsq_w(const f32x16 (&v)[2][4], float* red, float* __restrict__ ss_out, int m0, int nt) {
  const int tid = otid(), lane = tid & 63, w = tid >> 6, wm = w >> 1, wn = w & 1, r = lane & 31, h = lane >> 5;
  __syncthreads();
#pragma unroll
  for (int i = 0; i < 2; ++i)
#pragma unroll
    for (int reg = 0; reg < 16; ++reg) {
      float s = v[i][0][reg] * v[i][0][reg] + v[i][1][reg] * v[i][1][reg] + v[i][2][reg] * v[i][2][reg] + v[i][3][reg] * v[i][3][reg];
      s += dpp_x1(s); s += dpp_x2(s); s += dpp_x4(s); s += dpp_x8(s); s = swap_add16(s, s);
      if (r == 0) red[wn * 128 + wm * 64 + i * 32 + crow(reg, h)] = s;
    }
  __syncthreads();
  if (tid < 128) *(float2*)(ss_out + (size_t)(m0 + tid) * 8 + 2 * nt) = make_float2(red[tid] + red[128 + tid], 0.f);
}

#define TILE_LOOP(t, tiles) for (int slot_ = (obid() >> 3), per_ = (tiles) >> 3, t = (obid() & 7) * per_ + slot_; slot_ < per_; slot_ += (int)(gridDim.x >> 3), t += (int)(gridDim.x >> 3))

DI float rstd_of(const float* __restrict__ ss, int row) {
  const float4 a = *(const float4*)(ss + (size_t)row * 8), b = *(const float4*)(ss + (size_t)row * 8 + 4);
  return rsqrtf((a.x + a.y + a.z + a.w + b.x + b.y + b.z + b.w) * (1.f / 1024.f) + 1e-6f);
}

DI void tile_rowsumsq(const f32x16 (&v)[2][2], float* red, float* __restrict__ ss_out, int m0, int nt) {
  const int tid = otid(), lane = tid & 63, w = tid >> 6, wm = w >> 1, wn = w & 1, r = lane & 31, h = lane >> 5;
  __syncthreads();
#pragma unroll
  for (int i = 0; i < 2; ++i)
#pragma unroll
    for (int reg = 0; reg < 16; ++reg) {
      float s = v[i][0][reg] * v[i][0][reg] + v[i][1][reg] * v[i][1][reg];
      s += dpp_x1(s); s += dpp_x2(s); s += dpp_x4(s); s += dpp_x8(s); s = swap_add16(s, s);
      if (r == 0) red[wn * 128 + wm * 64 + i * 32 + crow(reg, h)] = s;
    }
  __syncthreads();
  if (tid < 128) ss_out[(size_t)(m0 + tid) * 8 + nt] = red[tid] + red[128 + tid];
}

#define EPI_LOOP(i, j, reg) _Pragma("unroll") for (int i = 0; i < 2; ++i) _Pragma("unroll") for (int j = 0; j < 2; ++j) _Pragma("unroll") for (int reg = 0; reg < 16; ++reg)

DI void phase_in(const Params& P, char* smem) {
  const int tid = otid(), lane = tid & 63, w = tid >> 6, wm = w >> 1, wn = w & 1, r = lane & 31, h = lane >> 5;
  const int NT = 8, tiles = (T_ / 128) * NT;
  TILE_LOOP(t, tiles) {
    const int mt = t / NT, nt = t % NT, m0 = mt * 128, n0 = nt * 256;
    f32x16 acc[2][4];
#pragma unroll
    for (int i = 0; i < 2; ++i)
#pragma unroll
      for (int j = 0; j < 4; ++j) acc[i][j] = zero16();
    float* rs_s = (float*)(smem + XTRA_OFF);
    const float myrs = (tid < 128) ? rstd_of(P.ssA, m0 + tid) : 0.f;
    gemm_mainloop_w(P.hb0 + (size_t)m0 * 1024, 1024, P.Wt_in + (size_t)n0 * 1024, 1024, 1024, acc, smem);
    if (tid < 128) rs_s[tid] = myrs;
    __syncthreads();
    ushort_t* dst = (nt < 4) ? (P.bufA + n0) : (P.bufB + n0 - 1024);
#pragma unroll
    for (int i = 0; i < 2; ++i)
#pragma unroll
      for (int reg = 0; reg < 16; ++reg) {
        const int rl = wm * 64 + i * 32 + crow(reg, h);
        const float rs = rs_s[rl];
#pragma unroll
        for (int j = 0; j < 4; ++j) {
          const int cl = wn * 128 + j * 32 + r;
          float v = acc[i][j][reg] * rs;
          if (nt < 4) v = gelu_tanh(v);
          dst[(size_t)(m0 + rl) * 1024 + cl] = f2bf(v);
        }
      }
  }
}

template <bool F32RES>
DI void phase_resid_gemm(const ushort_t* __restrict__ A, const ushort_t* __restrict__ Bt, const float* resid_f,
                         const ushort_t* resid_b, ushort_t* hb, float* __restrict__ ss, char* smem) {
  const int tid = otid(), lane = tid & 63, w = tid >> 6, wm = w >> 1, wn = w & 1, r = lane & 31, h = lane >> 5;
  float* red = (float*)(smem + XTRA_OFF + 512);
  const int NT = 4, tiles = (T_ / 128) * NT;
  TILE_LOOP(t, tiles) {
    const int mt = t / NT, nt = t % NT, m0 = mt * 128, n0 = nt * 256;
    f32x16 acc[2][4];
#pragma unroll
    for (int i = 0; i < 2; ++i)
#pragma unroll
      for (int j = 0; j < 4; ++j) acc[i][j] = zero16();
    gemm_mainloop_w(A + (size_t)m0 * 1024, 1024, Bt + (size_t)n0 * 1024, 1024, 1024, acc, smem);
#pragma unroll
    for (int i = 0; i < 2; ++i)
#pragma unroll
      for (int reg = 0; reg < 16; ++reg) {
        const int rl = wm * 64 + i * 32 + crow(reg, h);
        const unsigned off = (unsigned)(m0 + rl) * 1024u + (unsigned)(n0 + wn * 128 + r);
        ushort_t* bp = hb + off;
        float sq = 0.f;
#pragma unroll
        for (int j = 0; j < 4; ++j) {
          const float v = acc[i][j][reg] + (F32RES ? resid_f[off + j * 32] : bf2f(resid_b[off + j * 32]));
          bp[j * 32] = f2bf(v);
          sq += v * v;
        }
        sq += dpp_x1(sq); sq += dpp_x2(sq); sq += dpp_x4(sq); sq += dpp_x8(sq); sq = swap_add16(sq, sq);
        if (r == 0) red[wn * 128 + rl] = sq;
        if ((reg & 3) == 3) __builtin_amdgcn_sched_barrier(0);
      }
    __syncthreads();
    if (tid < 128) *(float2*)(ss + (size_t)(m0 + tid) * 8 + 2 * nt) = make_float2(red[tid] + red[128 + tid], 0.f);
  }
}

DI void phase_ple(const Params& P, int layer, const ushort_t* __restrict__ hb_in, ushort_t* __restrict__ hb_out,
                  const float* __restrict__ ss_in, float* __restrict__ ss_out, char* smem) {
  const int tid = otid(), lane = tid & 63, w = tid >> 6, wm = w >> 1, wn = w & 1, r = lane & 31, h = lane >> 5;
  float* red = (float*)(smem + XTRA_OFF + 512);
  const ushort_t* Wg = P.Wt_gate + (size_t)layer * 1024 * 1024;
  const ushort_t* Wp = P.Wt_proj + (size_t)layer * 256 * 1024;
  const ushort_t* pb = P.pb + (size_t)layer * T_ * 256;
  const int NT = 8, tiles = (T_ / 128) * NT;
  TILE_LOOP(t, tiles) {
    const int mt = t / NT, nt = t % NT, m0 = mt * 128, n0 = nt * 128;
    f32x16 acc[2][2], acc2[2][2];
    for (int i = 0; i < 2; ++i) for (int j = 0; j < 2; ++j) { acc[i][j] = zero16(); acc2[i][j] = zero16(); }
    float* rs_s = (float*)(smem + XTRA_OFF);
    const float myrs = (tid < 128) ? rstd_of(ss_in, m0 + tid) : 0.f;
    gemm_mainloop(hb_in + (size_t)m0 * 1024, 1024, Wg + (size_t)n0 * 1024, 1024, 1024, acc, smem);
    gemm_mainloop(pb + (size_t)m0 * 256, 256, Wp + (size_t)n0 * 256, 256, 256, acc2, smem);
    if (tid < 128) rs_s[tid] = myrs;
    __syncthreads();
#pragma unroll
    for (int i = 0; i < 2; ++i)
#pragma unroll
      for (int reg = 0; reg < 16; ++reg) {
        const int row = m0 + wm * 64 + i * 32 + crow(reg, h);
        const float rs = rs_s[row - m0];
#pragma unroll
        for (int j = 0; j < 2; ++j) {
          const int col = n0 + wn * 64 + j * 32 + r;
          const float gate = sigmoidf_(acc[i][j][reg] * rs);
          const float v = bf2f(hb_in[(size_t)row * 1024 + col]) + gate * acc2[i][j][reg];
          acc[i][j][reg] = v;
          hb_out[(size_t)row * 1024 + col] = f2bf(v);
        }
      }
    tile_rowsumsq(acc, red, ss_out, m0, nt);
  }
}

DI void phase_kvq(const Params& P, const ushort_t* __restrict__ hb_in, const float* __restrict__ ss_in, char* smem) {
  const int tid = otid(), lane = tid & 63, w = tid >> 6, wm = w >> 1, wn = w & 1, r = lane & 31, h = lane >> 5;
  const int NT = 12, tiles = (T_ / 128) * NT;
  TILE_LOOP(t, tiles) {
    const int mt = t / NT, nt = t % NT, m0 = mt * 128, n0 = nt * 256;
    f32x16 acc[2][4];
#pragma unroll
    for (int i = 0; i < 2; ++i)
#pragma unroll
      for (int j = 0; j < 4; ++j) acc[i][j] = zero16();
    float* rs_s = (float*)(smem + XTRA_OFF);
    const float myrs = (tid < 128) ? rstd_of(ss_in, m0 + tid) : 0.f;
    gemm_mainloop_w(hb_in + (size_t)m0 * 1024, 1024, P.Wt_kvq + (size_t)n0 * 1024, 1024, 1024, acc, smem);
    if (tid < 128) rs_s[tid] = myrs;
    __syncthreads();
    if (nt >= 4 && nt < 8) {
      constexpr int TS = 136;
      ushort_t* sT = (ushort_t*)smem;
#pragma unroll
      for (int i = 0; i < 2; ++i)
#pragma unroll
        for (int q4 = 0; q4 < 4; ++q4) {
          const int sl = wm * 64 + i * 32 + 8 * q4 + 4 * h;
          const float r0 = rs_s[sl], r1 = rs_s[sl + 1], r2 = rs_s[sl + 2], r3 = rs_s[sl + 3];
#pragma unroll
          for (int j = 0; j < 4; ++j) {
            const int d = wn * 128 + j * 32 + r;
            *(uint2*)(sT + d * TS + sl) = make_uint2(pk2(acc[i][j][q4 * 4 + 0] * r0, acc[i][j][q4 * 4 + 1] * r1),
                                                     pk2(acc[i][j][q4 * 4 + 2] * r2, acc[i][j][q4 * 4 + 3] * r3));
          }
        }
      __syncthreads();
      const int bb = m0 >> 11, s0 = m0 & 2047;
#pragma unroll
      for (int it = 0; it < 16; ++it) {
        const int c = tid + 256 * it, d = c >> 4, part = c & 15;
        const int col = n0 - 1024 + d, hh = col >> 6, dd = col & 63;
        const uint4 v = *(const uint4*)(sT + d * TS + part * 8);
        *(uint4*)(P.bufB + ((size_t)((bb * 16 + hh) * 64 + dd)) * 2048 + s0 + part * 8) = v;
      }
    } else {
#pragma unroll
      for (int i = 0; i < 2; ++i)
#pragma unroll
        for (int q4 = 0; q4 < 4; ++q4) {
          const int rowb = m0 + wm * 64 + i * 32 + 8 * q4 + 4 * h;
          float rs[4];
#pragma unroll
          for (int e = 0; e < 4; ++e) rs[e] = rs_s[rowb - m0 + e];
#pragma unroll
          for (int j = 0; j < 4; ++j) {
            const int col = n0 + wn * 128 + j * 32 + r;
            if (nt < 4) {
#pragma unroll
              for (int e = 0; e < 4; ++e) P.bufA[(size_t)(rowb + e) * 1024 + col] = f2bf(acc[i][j][q4 * 4 + e] * rs[e]);
            } else {
#pragma unroll
              for (int e = 0; e < 4; ++e) P.bufC[(size_t)(rowb + e) * 1024 + col - 2048] = f2bf(acc[i][j][q4 * 4 + e] * rs[e] * (0.125f * 1.4426950408889634f));
            }
          }
        }
    }
  }
}

DI void phase_lru(const Params& P, char* smem) {
  constexpr int XS = 136;
  ushort_t* sX = (ushort_t*)smem;
  float* sAa = (float*)(smem + 128 * XS * 2);
  float* sUu = sAa + 128 * 32;
  float* segA = sUu + 128 * 32;
  float* segU = segA + 256;
  float* carry = segU + 256;
  float* cw = carry + 64;
  float* cb = cw + 512;
  const int tid = otid(), lane = tid & 63, w = tid >> 6, r = lane & 31, h = lane >> 5;
  const int items = 16 * 8 * 4;
  for (int item = obid(); item < items; item += gridDim.x) {
    const int bhd = (item & 7) * 16 + (item >> 5), cgp = (item >> 3) & 3;
    const int b = bhd >> 3, hd = bhd & 7;
    __syncthreads();
    for (int idx = tid; idx < 512; idx += NTHR) cw[idx] = P.a_conv_w[(idx >> 7) * 1024 + hd * 128 + (idx & 127)];
    if (tid < 128) cb[tid] = P.a_conv_b[hd * 128 + tid];
    if (tid < 32) carry[tid] = 0.f;
    bf16x8 br[8], bi[8];
#pragma unroll
    for (int kk = 0; kk < 8; ++kk) {
      br[kk] = *(const bf16x8*)(P.Wt_r + (size_t)(hd * 128 + cgp * 32 + r) * 128 + kk * 16 + h * 8);
      bi[kk] = *(const bf16x8*)(P.Wt_i + (size_t)(hd * 128 + cgp * 32 + r) * 128 + kk * 16 + h * 8);
    }
    const int ch = hd * 128 + cgp * 32 + r;
    const float bR = P.a_b_r[ch], bI = P.a_b_i[ch];
    const float nl = -P.a_lambda[ch];
    const float c8 = -8.f * (fmaxf(nl, 0.f) + log1pf(__expf(-fabsf(nl))));
    __syncthreads();
    const int cch = tid & 15;
    uint4 xa0, xa1, xa2, xa3, xa4, xa5, xa6, xb0, xb1, xb2, xb3, xb4, xb5, xb6;
    const ushort_t* xbase = P.bufB + ((size_t)b * S_) * 1024 + hd * 128 + cch * 8;
#define LRU_XLOAD(tt0) { \
      const int ra_ = (tt0) + (tid >> 4) * 4 - 3, rb_ = ra_ + 64; \
      const ushort_t* pa_ = xbase + (ptrdiff_t)ra_ * 1024; const ushort_t* pb_ = xbase + (ptrdiff_t)rb_ * 1024; \
      const uint4 z4_ = make_uint4(0, 0, 0, 0); const bool fz_ = ra_ < 0; \
      xa0 = fz_ ? z4_ : *(const uint4*)(pa_); xa1 = fz_ ? z4_ : *(const uint4*)(pa_ + 1024); xa2 = fz_ ? z4_ : *(const uint4*)(pa_ + 2048); \
      xa3 = *(const uint4*)(pa_ + 3 * 1024); xa4 = *(const uint4*)(pa_ + 4 * 1024); xa5 = *(const uint4*)(pa_ + 5 * 1024); xa6 = *(const uint4*)(pa_ + 6 * 1024); \
      xb0 = *(const uint4*)(pb_); xb1 = *(const uint4*)(pb_ + 1024); xb2 = *(const uint4*)(pb_ + 2048); xb3 = *(const uint4*)(pb_ + 3 * 1024); \
      xb4 = *(const uint4*)(pb_ + 4 * 1024); xb5 = *(const uint4*)(pb_ + 5 * 1024); xb6 = *(const uint4*)(pb_ + 6 * 1024); }
    LRU_XLOAD(0);
    for (int tile = 0; tile < 16; ++tile) {
      const int t0 = tile * 128;
      const int scol = tid & 31, sseg = tid >> 5;
      const size_t gbase = ((size_t)b * S_ + t0 + sseg * 16) * 1024 + hd * 128 + cgp * 32 + scol;
      {
        float wv[4][8], bv[8];
#pragma unroll
        for (int c = 0; c < 8; ++c) { bv[c] = cb[cch * 8 + c];
#pragma unroll
          for (int k = 0; k < 4; ++k) wv[k][c] = cw[k * 128 + cch * 8 + c]; }
#define CONV_TAP(k, q) a[0] += wv[k][0] * bf_lo(q.x); a[1] += wv[k][1] * bf_hi(q.x); a[2] += wv[k][2] * bf_lo(q.y); a[3] += wv[k][3] * bf_hi(q.y); \
          a[4] += wv[k][4] * bf_lo(q.z); a[5] += wv[k][5] * bf_hi(q.z); a[6] += wv[k][6] * bf_lo(q.w); a[7] += wv[k][7] * bf_hi(q.w);
#define CONV_ROW(rowl, q0, q1, q2, q3) { float a[8]; \
          _Pragma("unroll") for (int c = 0; c < 8; ++c) a[c] = bv[c]; \
          CONV_TAP(0, q0) CONV_TAP(1, q1) CONV_TAP(2, q2) CONV_TAP(3, q3) \
          *(uint4*)(sX + (rowl) * XS + cch * 8) = make_uint4(pk2(a[0], a[1]), pk2(a[2], a[3]), pk2(a[4], a[5]), pk2(a[6], a[7])); }
        const int r0 = (tid >> 4) * 4;
        CONV_ROW(r0 + 0, xa0, xa1, xa2, xa3) CONV_ROW(r0 + 1, xa1, xa2, xa3, xa4) CONV_ROW(r0 + 2, xa2, xa3, xa4, xa5) CONV_ROW(r0 + 3, xa3, xa4, xa5, xa6)
        CONV_ROW(r0 + 64, xb0, xb1, xb2, xb3) CONV_ROW(r0 + 65, xb1, xb2, xb3, xb4) CONV_ROW(r0 + 66, xb2, xb3, xb4, xb5) CONV_ROW(r0 + 67, xb3, xb4, xb5, xb6)
#undef CONV_ROW
#undef CONV_TAP
      }
      __syncthreads();
      LRU_XLOAD((tile < 15 ? tile + 1 : 15) * 128);
      ushort_t yv[16];
#pragma unroll
      for (int i = 0; i < 16; ++i) yv[i] = P.bufA[gbase + (size_t)i * 1024];
      __builtin_amdgcn_sched_barrier(0);
      f32x16 accr = zero16(), acci = zero16();
#pragma unroll
      for (int kk = 0; kk < 8; ++kk) {
        const bf16x8 a = *(const bf16x8*)(sX + (w * 32 + r) * XS + kk * 16 + h * 8);
        accr = mfma32(a, br[kk], accr);
        acci = mfma32(a, bi[kk], acci);
      }
#pragma unroll
      for (int reg = 0; reg < 16; ++reg) {
        const int row = w * 32 + crow(reg, h);
        const float xcv = bf2f(sX[row * XS + cgp * 32 + r]);
        const float rr = sigmoidf_(accr[reg] + bR), ii = sigmoidf_(acci[reg] + bI);
        const float la = c8 * rr;
        const float a = __expf(la);
        const float u = sqrtf(fmaxf(1.f - __expf(2.f * la), 0.f)) * ii * xcv;
        sAa[row * 32 + r] = a; sUu[row * 32 + r] = u;
      }
      __syncthreads();
      {
        const int col = scol, seg = sseg;
        float Aa = 1.f, Uu = 0.f;
#pragma unroll
        for (int i = 0; i < 16; ++i) { const float a = sAa[(seg * 16 + i) * 32 + col], u = sUu[(seg * 16 + i) * 32 + col]; Uu = a * Uu + u; Aa *= a; }
        segA[seg * 32 + col] = Aa; segU[seg * 32 + col] = Uu;
        __syncthreads();
        float hin = carry[(tile & 1) * 32 + col];
        for (int s2 = 0; s2 < seg; ++s2) hin = segA[s2 * 32 + col] * hin + segU[s2 * 32 + col];
#pragma unroll
        for (int i = 0; i < 16; ++i) {
          const float a = sAa[(seg * 16 + i) * 32 + col], u = sUu[(seg * 16 + i) * 32 + col];
          hin = a * hin + u;
          P.bufC[gbase + (size_t)i * 1024] = f2bf(bf2f(yv[i]) * hin);
        }
        if (seg == 7) carry[((tile + 1) & 1) * 32 + col] = hin;
      }
    }
#undef LRU_XLOAD
  }
}

template <bool MASK>
DI void sb_subtile(const f32x16& sreg, float& prun, f32x16& aout, int key0, int qidx, int h) {
  float bt[16], om[16];
#pragma unroll
  for (int i = 0; i < 16; ++i) {
    const float z = fmaxf(sreg[i], -115.f);
    const float e = __builtin_amdgcn_exp2f(-z);
    float bb = __builtin_amdgcn_rcpf(1.f + e);
    float oo = e * bb;
    if (MASK) { const bool ok = (key0 + crow(i, h)) < qidx; bb = ok ? bb : 0.f; oo = ok ? oo : 1.f; }
    bt[i] = bb; om[i] = oo;
  }
  float G[4], Gp[4];
#pragma unroll
  for (int g = 0; g < 4; ++g) { G[g] = (om[4 * g] * om[4 * g + 1]) * (om[4 * g + 2] * om[4 * g + 3]); Gp[g] = plx32(G[g], h != 0); }
  float E[4];
  float run = prun;
#pragma unroll
  for (int g = 3; g >= 0; --g) {
    const float ghi = h ? G[g] : Gp[g];
    const float glo = h ? Gp[g] : G[g];
    const float e_hi = run;
    run *= ghi;
    const float e_lo = run;
    run *= glo;
    E[g] = h ? e_hi : e_lo;
  }
  prun = run;
#pragma unroll
  for (int g = 0; g < 4; ++g) {
    float s = E[g];
    aout[4 * g + 3] = bt[4 * g + 3] * s; s *= om[4 * g + 3];
    aout[4 * g + 2] = bt[4 * g + 2] * s; s *= om[4 * g + 2];
    aout[4 * g + 1] = bt[4 * g + 1] * s; s *= om[4 * g + 1];
    aout[4 * g + 0] = bt[4 * g + 0] * s;
  }
}

DI void phase_attn(const Params& P, char* smem) {
  constexpr int KS = 72;
  ushort_t* sK = (ushort_t*)smem;
  ushort_t* sV = sK + 64 * KS;
  const int tid = otid(), lane = tid & 63, w = tid >> 6, r = lane & 31, h = lane >> 5;
  const int items = 16 * 256;
  for (int item = obid(); item < items; item += gridDim.x) {
    const int slot = item >> 8, wi = slot & 3;
    const int qt = 15 - 4 * (slot >> 2) - (wi == 0 ? 0 : wi == 1 ? 1 : wi == 2 ? 3 : 2);
    const int bh = item & 255, b = bh >> 4, hh = bh & 15;
    const int q0 = qt * 128, qw0 = q0 + w * 32, qidx = qw0 + r;
    ushort_t* qptr = P.bufC + ((size_t)b * S_ + qidx) * 1024 + hh * 64;
    bf16x8 qf[4];
#pragma unroll
    for (int kk = 0; kk < 4; ++kk) qf[kk] = *(const bf16x8*)(qptr + kk * 16 + h * 8);
    f32x16 o0 = zero16(), o1 = zero16();
    float prun = 1.f;
    const int lrow = tid >> 3, lcol = (tid & 7) * 8;
    const ushort_t* kbase = P.bufA + ((size_t)b * S_) * 1024 + hh * 64;
    const ushort_t* vbase = P.bufB + ((size_t)(b * 16 + hh) * 64) * 2048;
    const int ktmax = 2 * qt + 1;
    uint4 rk0, rk1, rv0, rv1;
    rk0 = *(const uint4*)(kbase + (size_t)(ktmax * 64 + lrow) * 1024 + lcol);
    rk1 = *(const uint4*)(kbase + (size_t)(ktmax * 64 + lrow + 32) * 1024 + lcol);
    rv0 = *(const uint4*)(vbase + (size_t)(lrow) * 2048 + ktmax * 64 + lcol);
    rv1 = *(const uint4*)(vbase + (size_t)(lrow + 32) * 2048 + ktmax * 64 + lcol);
    volatile int* dflag = (volatile int*)(smem + 2 * 64 * KS * 2);
    bool wdone = false;
    if (tid < 4) dflag[tid] = 0;
    for (int kt = ktmax; kt >= 0; --kt) {
      __syncthreads();
      if ((dflag[0] & dflag[1] & dflag[2] & dflag[3]) != 0) break;
      *(uint4*)(sK + (lrow) * KS + lcol) = rk0; *(uint4*)(sK + (lrow + 32) * KS + lcol) = rk1;
      *(uint4*)(sV + (lrow) * KS + lcol) = rv0; *(uint4*)(sV + (lrow + 32) * KS + lcol) = rv1;
      __syncthreads();
      if (kt > 0) {
        rk0 = *(const uint4*)(kbase + (size_t)((kt - 1) * 64 + lrow) * 1024 + lcol);
        rk1 = *(const uint4*)(kbase + (size_t)((kt - 1) * 64 + lrow + 32) * 1024 + lcol);
        rv0 = *(const uint4*)(vbase + (size_t)(lrow) * 2048 + (kt - 1) * 64 + lcol);
        rv1 = *(const uint4*)(vbase + (size_t)(lrow + 32) * 2048 + (kt - 1) * 64 + lcol);
      }
      if (kt * 64 <= qw0 + 30 && !wdone) {
        const bool need_mask = (kt * 64 + 63 >= qw0);
#pragma unroll
        for (int sub = 1; sub >= 0; --sub) {
          f32x16 s = zero16();
#pragma unroll
          for (int kk = 0; kk < 4; ++kk) {
            const bf16x8 kf = *(const bf16x8*)(sK + (sub * 32 + r) * KS + kk * 16 + h * 8);
            s = mfma32(kf, qf[kk], s);
          }
          f32x16 a;
          if (need_mask) sb_subtile<true>(s, prun, a, kt * 64 + sub * 32, qidx, h);
          else sb_subtile<false>(s, prun, a, kt * 64 + sub * 32, qidx, h);
#pragma unroll
          for (int st = 0; st < 2; ++st) {
            bf16x8 pf;
            {
              const unsigned p0 = pk2(a[8 * st + 0], a[8 * st + 1]), p1 = pk2(a[8 * st + 2], a[8 * st + 3]);
              const unsigned p2 = pk2(a[8 * st + 4], a[8 * st + 5]), p3 = pk2(a[8 * st + 6], a[8 * st + 7]);
              uint4 pq = make_uint4(p0, p1, p2, p3);
              pf = __builtin_bit_cast(bf16x8, pq);
            }
#pragma unroll
            for (int dt = 0; dt < 2; ++dt) {
              const ushort_t* vp = sV + (dt * 32 + r) * KS + sub * 32 + 16 * st + 4 * h;
              const uint2 v0 = *(const uint2*)vp, v1 = *(const uint2*)(vp + 8);
              uint4 vq = make_uint4(v0.x, v0.y, v1.x, v1.y);
              const bf16x8 vf = __builtin_bit_cast(bf16x8, vq);
              if (dt == 0) o0 = mfma32(vf, pf, o0); else o1 = mfma32(vf, pf, o1);
            }
          }
        }
      }
      if (!wdone && __all((int)(prun < 1e-30f))) { wdone = true; if (lane == 0) dflag[w] = 1; }
    }
    __syncthreads();
#pragma unroll
    for (int g = 0; g < 4; ++g) {
      *(uint2*)(qptr + 8 * g + 4 * h) = make_uint2(pk2(o0[4 * g], o0[4 * g + 1]), pk2(o0[4 * g + 2], o0[4 * g + 3]));
      *(uint2*)(qptr + 32 + 8 * g + 4 * h) = make_uint2(pk2(o1[4 * g], o1[4 * g + 1]), pk2(o1[4 * g + 2], o1[4 * g + 3]));
    }
  }
}

DI void ins16(float (&L)[16], float x) {
#pragma unroll
  for (int i = 0; i < 16; ++i) { const float hi = fmaxf(L[i], x); x = fminf(L[i], x); L[i] = hi; }
}

DI void merge16(float (&L)[16], const float (&O)[16]) {
#pragma unroll
  for (int i = 0; i < 16; ++i) L[i] = fmaxf(L[i], O[15 - i]);
#pragma unroll
  for (int st = 8; st >= 1; st >>= 1)
#pragma unroll
    for (int i = 0; i < 16; ++i)
      if ((i & st) == 0) { const float a = L[i], b = L[i + st]; L[i] = fmaxf(a, b); L[i + st] = fminf(a, b); }
}

DI void sort16(float (&v)[16]) {
#pragma unroll
  for (int k = 2; k <= 16; k <<= 1)
#pragma unroll
    for (int j = k >> 1; j > 0; j >>= 1)
#pragma unroll
      for (int i = 0; i < 16; ++i) {
        const int l = i ^ j;
        if (l > i) {
          const bool desc = ((i & k) == 0);
          const float a = v[i], b = v[l];
          const float mx = fmaxf(a, b), mn = fminf(a, b);
          v[i] = desc ? mx : mn; v[l] = desc ? mn : mx;
        }
      }
}

DI void phase_route(const Params& P, int layer, const ushort_t* __restrict__ hb_in, const float* __restrict__ ss_in, char* smem) {
  constexpr int QS = 136, SS = 129;
  ushort_t* sQ = (ushort_t*)(smem + GEMM_BUF);
  float* sS = (float*)smem;
  const int tid = otid(), lane = tid & 63, w = tid >> 6, wm = w >> 1, wn = w & 1, r = lane & 31, h = lane >> 5;
  const ushort_t* Wq = P.Wt_pq + (size_t)layer * 2048 * 1024;
  const ushort_t* SKl = P.SK + (size_t)layer * 8 * 2 * 128 * 128;
  const int items = (T_ / 128) * 8;
  TILE_LOOP(item, items) {
    const int mt = item >> 3, hd = item & 7, m0 = mt * 128;
    const int trow = (tid & 31) + 32 * (tid >> 6), half = (tid >> 5) & 1;
    float L0[16], L1[16];
#pragma unroll
    for (int p = 0; p < 2; ++p) {
      f32x16 acc[2][2]; for (int i = 0; i < 2; ++i) for (int j = 0; j < 2; ++j) acc[i][j] = zero16();
      gemm_mainloop(hb_in + (size_t)m0 * 1024, 1024, Wq + (size_t)(hd * 256 + p * 128) * 1024, 1024, 1024, acc, smem);
      EPI_LOOP(i, j, reg) {
        const int row = wm * 64 + i * 32 + crow(reg, h), col = wn * 64 + j * 32 + r;
        sQ[row * QS + col] = f2bf(acc[i][j][reg]);
      }
      __syncthreads();
      for (int i = 0; i < 2; ++i) for (int j = 0; j < 2; ++j) acc[i][j] = zero16();
      const ushort_t* skp = SKl + (size_t)((hd * 2 + p) * 128) * 128;
#pragma unroll
      for (int kk = 0; kk < 8; ++kk) {
        const bf16x8 a0 = *(const bf16x8*)(sQ + (wm * 64 + r) * QS + kk * 16 + h * 8);
        const bf16x8 a1 = *(const bf16x8*)(sQ + (wm * 64 + 32 + r) * QS + kk * 16 + h * 8);
        const bf16x8 b0 = *(const bf16x8*)(skp + (size_t)(wn * 64 + r) * 128 + kk * 16 + h * 8);
        const bf16x8 b1 = *(const bf16x8*)(skp + (size_t)(wn * 64 + 32 + r) * 128 + kk * 16 + h * 8);
        acc[0][0] = mfma32(a0, b0, acc[0][0]); acc[0][1] = mfma32(a0, b1, acc[0][1]);
        acc[1][0] = mfma32(a1, b0, acc[1][0]); acc[1][1] = mfma32(a1, b1, acc[1][1]);
      }
      __syncthreads();
      EPI_LOOP(i, j, reg) {
        const int row = wm * 64 + i * 32 + crow(reg, h), col = wn * 64 + j * 32 + r;
        sS[row * SS + col] = acc[i][j][reg];
      }
      __syncthreads();
      float L[16];
#pragma unroll 1
      for (int blk = 0; blk < 4; ++blk) {
        float Sv[16];
#pragma unroll
        for (int c = 0; c < 16; ++c) {
          const int n = half * 64 + blk * 16 + c;
          const float v = sS[trow * SS + n];
          Sv[c] = __uint_as_float((__float_as_uint(v) & ~0x7Fu) | (unsigned)(127 - n));
        }
        sort16(Sv);
        if (blk == 0) {
#pragma unroll
          for (int i = 0; i < 16; ++i) L[i] = Sv[i];
        } else merge16(L, Sv);
      }
      float O[16];
#pragma unroll
      for (int i = 0; i < 16; ++i) O[i] = plx32(L[i], half != 0);
      merge16(L, O);
#pragma unroll
      for (int i = 0; i < 16; ++i) { if (p == 0) L0[i] = L[i]; else L1[i] = L[i]; }
      __syncthreads();
    }
    float F[16];
#pragma unroll
    for (int j = 0; j < 16; ++j) F[j] = __uint_as_float((__float_as_uint(L0[0] + L1[j]) & ~0xFFu) | (unsigned)(255 - j));
#pragma unroll
    for (int i = 1; i < 16; ++i)
#pragma unroll
      for (int j = 0; j < 16; ++j)
        if ((i + 1) * (j + 1) <= 16) {
          const float c = L0[i] + L1[j];
          ins16(F, __uint_as_float((__float_as_uint(c) & ~0xFFu) | (unsigned)(255 - (i * 16 + j))));
        }
    float* slot = sS + tid * 33;
#pragma unroll
    for (int i = 0; i < 16; ++i) { slot[i] = L0[i]; slot[16 + i] = L1[i]; }
    const float rs = rstd_of(ss_in, m0 + trow);
    float ex[16], sum = 0.f;
#pragma unroll
    for (int k = 0; k < 16; ++k) { ex[k] = __expf((F[k] - F[0]) * rs); sum += ex[k]; }
    const float inv = 1.f / sum;
    if (half == 0) {
      unsigned ei[16];
#pragma unroll
      for (int k = 0; k < 16; ++k) {
        const unsigned ci = 255u - (__float_as_uint(F[k]) & 0xFFu);
        const unsigned i1 = 127u - (__float_as_uint(slot[ci >> 4]) & 0x7Fu);
        const unsigned i2 = 127u - (__float_as_uint(slot[16 + (ci & 15)]) & 0x7Fu);
        ei[k] = i1 * 128u + i2;
      }
      ushort_t* ep = P.eidx + (size_t)(m0 + trow) * 128 + hd * 16;
      *(uint4*)ep = make_uint4(ei[0] | (ei[1] << 16), ei[2] | (ei[3] << 16), ei[4] | (ei[5] << 16), ei[6] | (ei[7] << 16));
      *(uint4*)(ep + 8) = make_uint4(ei[8] | (ei[9] << 16), ei[10] | (ei[11] << 16), ei[12] | (ei[13] << 16), ei[14] | (ei[15] << 16));
      float* gp = P.gw + (size_t)(m0 + trow) * 128 + hd * 16;
#pragma unroll
      for (int k = 0; k < 16; k += 4) *(float4*)(gp + k) = make_float4(ex[k] * inv, ex[k + 1] * inv, ex[k + 2] * inv, ex[k + 3] * inv);
    }
    __syncthreads();
  }
}

DI void phase_expert_u(const Params& P, int layer, const ushort_t* __restrict__ hb, ushort_t* __restrict__ P8) {
  const int tid = otid(), lane = tid & 63, w = tid >> 6, b = obid();
  const int part = b & 7, wv = (b >> 3) * 4 + w, nwv = (gridDim.x >> 3) * 4;
  const int pg = lane >> 3, cl = lane & 7;
  const bool b0 = lane & 1, b1 = lane & 2, b2 = lane & 4;
  const unsigned char* Ub = P.Ub8 + (size_t)layer * 16384 * 1024 + part * 128 + cl * 16;
  ushort_t* pout = P8 + (size_t)part * T_ * 128;
  const int it0 = (b2 ? 2 : 0) + (b1 ? 4 : 0) + (b0 ? 8 : 0);
  int ne_lo, ne_hi; uint4 nxa, nxb;
#define U_LOADTOK(tt) { ne_lo = P.eidx[(size_t)(tt) * 128 + lane]; ne_hi = P.eidx[(size_t)(tt) * 128 + 64 + lane]; \
    nxa = *(const uint4*)(hb + (size_t)(tt) * 1024 + part * 128 + cl * 16); nxb = *(const uint4*)(hb + (size_t)(tt) * 1024 + part * 128 + cl * 16 + 8); }
  int t = wv;
  if (t < T_) U_LOADTOK(t);
  for (; t < T_; t += nwv) {
    const int e_lo = ne_lo, e_hi = ne_hi; const uint4 xa = nxa, xb = nxb;
    if (t + nwv < T_) U_LOADTOK(t + nwv);
    __builtin_amdgcn_sched_barrier(0);
    f32x2 x2[8];
    x2[0] = f32x2{bf_lo(xa.x), bf_hi(xa.x)}; x2[1] = f32x2{bf_lo(xa.y), bf_hi(xa.y)}; x2[2] = f32x2{bf_lo(xa.z), bf_hi(xa.z)}; x2[3] = f32x2{bf_lo(xa.w), bf_hi(xa.w)};
    x2[4] = f32x2{bf_lo(xb.x), bf_hi(xb.x)}; x2[5] = f32x2{bf_lo(xb.y), bf_hi(xb.y)}; x2[6] = f32x2{bf_lo(xb.z), bf_hi(xb.z)}; x2[7] = f32x2{bf_lo(xb.w), bf_hi(xb.w)};
    uint4 row[16];
#pragma unroll
    for (int i = 0; i < 16; ++i) {
      const int src = (8 * i + pg) & 63;
      const int e = __shfl(i < 8 ? e_lo : e_hi, src);
      row[i] = *(const uint4*)(Ub + (size_t)e * 1024);
    }
    float p[16];
#pragma unroll
    for (int i = 0; i < 16; ++i) {
      const uint4 rw = row[i];
      f32x2 a = {0.f, 0.f};
      a += __builtin_amdgcn_cvt_pk_f32_fp8((int)rw.x, false) * x2[0]; a += __builtin_amdgcn_cvt_pk_f32_fp8((int)rw.x, true) * x2[1];
      a += __builtin_amdgcn_cvt_pk_f32_fp8((int)rw.y, false) * x2[2]; a += __builtin_amdgcn_cvt_pk_f32_fp8((int)rw.y, true) * x2[3];
      a += __builtin_amdgcn_cvt_pk_f32_fp8((int)rw.z, false) * x2[4]; a += __builtin_amdgcn_cvt_pk_f32_fp8((int)rw.z, true) * x2[5];
      a += __builtin_amdgcn_cvt_pk_f32_fp8((int)rw.w, false) * x2[6]; a += __builtin_amdgcn_cvt_pk_f32_fp8((int)rw.w, true) * x2[7];
      p[i] = a.x + a.y;
    }
    float r8[8], r4[4], r2[2];
#pragma unroll
    for (int i = 0; i < 8; ++i) r8[i] = (b0 ? p[i + 8] : p[i]) + dpp_x1(b0 ? p[i] : p[i + 8]);
#pragma unroll
    for (int i = 0; i < 4; ++i) r4[i] = (b1 ? r8[i + 4] : r8[i]) + dpp_x2(b1 ? r8[i] : r8[i + 4]);
#pragma unroll
    for (int i = 0; i < 2; ++i) r2[i] = (b2 ? r4[i + 2] : r4[i]) + dpp_x4(b2 ? r4[i] : r4[i + 2]);
    ushort_t* po = pout + (size_t)t * 128 + 8 * it0 + pg;
    po[0] = f2bf(r2[0]); po[8] = f2bf(r2[1]);
  }
#undef U_LOADTOK
}

DI void phase_expert_combine(const Params& P, const ushort_t* __restrict__ P8, ushort_t* __restrict__ wb, const float* __restrict__ ss_in) {
  const size_t n4 = (size_t)T_ * 128 / 4, stride = (size_t)gridDim.x * NTHR;
  for (size_t i = (size_t)obid() * NTHR + otid(); i < n4; i += stride) {
    const int t = (int)(i >> 5);
    float4 sacc = make_float4(0.f, 0.f, 0.f, 0.f);
#pragma unroll
    for (int q = 0; q < 8; ++q) {
      const uint2 v = *(const uint2*)(P8 + (size_t)q * T_ * 128 + i * 4);
      sacc.x += bf_lo(v.x); sacc.y += bf_hi(v.x); sacc.z += bf_lo(v.y); sacc.w += bf_hi(v.y);
    }
    const float rs = rstd_of(ss_in, t) * (1.f / U_SCALE);
    const float4 g = *(const float4*)(P.gw + i * 4);
    const float w0 = g.x * gelu_tanh(sacc.x * rs) * (1.f / V_SCALE), w1 = g.y * gelu_tanh(sacc.y * rs) * (1.f / V_SCALE);
    const float w2 = g.z * gelu_tanh(sacc.z * rs) * (1.f / V_SCALE), w3 = g.w * gelu_tanh(sacc.w * rs) * (1.f / V_SCALE);
    *(uint2*)(wb + i * 4) = make_uint2(pk2(w0, w1), pk2(w2, w3));
  }
}

DI void phase_expert_v(const Params& P, int layer, ushort_t* __restrict__ hb, const ushort_t* __restrict__ wb,
                       const float* __restrict__ ss_in, float* __restrict__ ss_out) {
  const int tid = otid(), lane = tid & 63, w = tid >> 6, b = obid();
  const int part = b & 7, wv = (b >> 3) * 4 + w, nwv = (gridDim.x >> 3) * 4;
  const int pg = lane >> 3, cl = lane & 7;
  const bool b5 = lane & 32, b4 = lane & 16, b3 = lane & 8;
  const int col = part * 128 + cl * 16 + (b5 ? 8 : 0) + (b4 ? 4 : 0) + (b3 ? 2 : 0);
  const unsigned char* Vb = P.Vb8 + (size_t)layer * 16384 * 1024 + part * 128 + cl * 16;
  int ne_lo, ne_hi; float ng_lo, ng_hi; unsigned nhp;
#define V_LOADTOK(tt) { ne_lo = P.eidx[(size_t)(tt) * 128 + lane]; ne_hi = P.eidx[(size_t)(tt) * 128 + 64 + lane]; \
    ng_lo = bf2f(wb[(size_t)(tt) * 128 + lane]); ng_hi = bf2f(wb[(size_t)(tt) * 128 + 64 + lane]); \
    nhp = *(const unsigned*)(hb + (size_t)(tt) * 1024 + col); }
  int t = wv;
  if (t < T_) V_LOADTOK(t);
  for (; t < T_; t += nwv) {
    const int e_lo = ne_lo, e_hi = ne_hi; float2 hv = make_float2(bf_lo(nhp), bf_hi(nhp));
    const float w_lo = ng_lo, w_hi = ng_hi;
    if (t + nwv < T_) V_LOADTOK(t + nwv);
    __builtin_amdgcn_sched_barrier(0);
    f32x2 acc[8];
#pragma unroll
    for (int i = 0; i < 8; ++i) acc[i] = f32x2{0.f, 0.f};
    uint4 row[16]; float wg[16];
#pragma unroll
    for (int i = 0; i < 16; ++i) {
      const int src = (8 * i + pg) & 63;
      const int e = __shfl(i < 8 ? e_lo : e_hi, src);
      wg[i] = __shfl(i < 8 ? w_lo : w_hi, src);
      row[i] = *(const uint4*)(Vb + (size_t)e * 1024);
    }
#pragma unroll
    for (int i = 0; i < 16; ++i) {
      const f32x2 w2 = {wg[i], wg[i]};
      acc[0] += __builtin_amdgcn_cvt_pk_f32_fp8((int)row[i].x, false) * w2; acc[1] += __builtin_amdgcn_cvt_pk_f32_fp8((int)row[i].x, true) * w2;
      acc[2] += __builtin_amdgcn_cvt_pk_f32_fp8((int)row[i].y, false) * w2; acc[3] += __builtin_amdgcn_cvt_pk_f32_fp8((int)row[i].y, true) * w2;
      acc[4] += __builtin_amdgcn_cvt_pk_f32_fp8((int)row[i].z, false) * w2; acc[5] += __builtin_amdgcn_cvt_pk_f32_fp8((int)row[i].z, true) * w2;
      acc[6] += __builtin_amdgcn_cvt_pk_f32_fp8((int)row[i].w, false) * w2; acc[7] += __builtin_amdgcn_cvt_pk_f32_fp8((int)row[i].w, true) * w2;
    }
    f32x2 r4[4], r2[2], r1;
#pragma unroll
    for (int i = 0; i < 4; ++i) {
      r4[i] = f32x2{swap_add32(acc[i].x, acc[i + 4].x), swap_add32(acc[i].y, acc[i + 4].y)};
    }
#pragma unroll
    for (int i = 0; i < 2; ++i) {
      r2[i] = f32x2{swap_add16(r4[i].x, r4[i + 2].x), swap_add16(r4[i].y, r4[i + 2].y)};
    }
    {
      const f32x2 keep = b3 ? r2[1] : r2[0], send = b3 ? r2[0] : r2[1];
      r1 = keep + f32x2{dpp_x8(send.x), dpp_x8(send.y)};
    }
    hv.x += r1.x; hv.y += r1.y;
    *(unsigned*)(hb + (size_t)t * 1024 + col) = pk2(hv.x, hv.y);
    float sq = hv.x * hv.x + hv.y * hv.y;
    sq += dpp_x1(sq); sq += dpp_x2(sq); sq += dpp_x4(sq); sq += dpp_x8(sq); sq = swap_add16(sq, sq); sq = swap_add32(sq, sq);
    if (lane == 0) ss_out[(size_t)t * 8 + part] = sq;
  }
#undef V_LOADTOK
}

DI void phase_final(const Params& P, const ushort_t* __restrict__ hb, const float* __restrict__ ss) {
  const size_t n8 = (size_t)T_ * 1024 / 8, stride = (size_t)gridDim.x * NTHR;
  for (size_t i0 = (size_t)obid() * NTHR + otid(); i0 < n8; i0 += 4 * stride) {
    uint4 u[4]; float4 sa[4], sb[4];
#pragma unroll
    for (int q = 0; q < 4; ++q) {
      const size_t i = i0 + q * stride;
      u[q] = *(const uint4*)(hb + i * 8);
      sa[q] = *(const float4*)(ss + (i >> 7) * 8); sb[q] = *(const float4*)(ss + (i >> 7) * 8 + 4);
    }
#pragma unroll
    for (int q = 0; q < 4; ++q) {
      const size_t i = i0 + q * stride;
      const int c = (int)(i & 127) * 8;
      const float rs = rsqrtf((sa[q].x + sa[q].y + sa[q].z + sa[q].w + sb[q].x + sb[q].y + sb[q].z + sb[q].w) * (1.f / 1024.f) + 1e-6f);
      const float4 g0 = *(const float4*)(P.final_norm + c), g1 = *(const float4*)(P.final_norm + c + 4);
      *(float4*)(P.h + i * 8) = make_float4(bf_lo(u[q].x) * rs * g0.x, bf_hi(u[q].x) * rs * g0.y, bf_lo(u[q].y) * rs * g0.z, bf_hi(u[q].y) * rs * g0.w);
      *(float4*)(P.h + i * 8 + 4) = make_float4(bf_lo(u[q].z) * rs * g1.x, bf_hi(u[q].z) * rs * g1.y, bf_lo(u[q].w) * rs * g1.z, bf_hi(u[q].w) * rs * g1.w);
    }
  }
}

#define XB_TMO      128
#define XB_XCNT(j)  (256  + 64 * (j))
#define XB_XSUB(j)  (1280 + 64 * (j))
#define XB_XGEN(j)  (2304 + 64 * (j))
#define XB_TOP      3328
#define XB_TOPGEN   3392
#define XCD_BAR_WORDS 3456
#define XB_SPIN_CAP (1u << 22)
#define LAS __attribute__((address_space(3)))
DI unsigned xb_ld(unsigned* p) { return __hip_atomic_load(p, __ATOMIC_RELAXED, __HIP_MEMORY_SCOPE_AGENT); }
DI unsigned xb_add(unsigned* p, unsigned v) { return __hip_atomic_fetch_add(p, v, __ATOMIC_RELAXED, __HIP_MEMORY_SCOPE_AGENT); }
DI unsigned xb_xcc_id() { return (unsigned)__builtin_amdgcn_s_getreg((3 << 11) | 20) & 0xFu; }
#define XB_SPIN(cond, bar) do { unsigned _sp = 0; while (cond) { __builtin_amdgcn_s_sleep(1); \
    if ((++_sp & 255u) == 0u) { if (xb_ld(&(bar)[XB_TMO])) break; if (_sp > XB_SPIN_CAP) { atomicAdd(&(bar)[XB_TMO], 1u); break; } } } } while (0)
struct XcdBarrier { unsigned* bar; unsigned x; volatile LAS unsigned* st; };
DI XcdBarrier xcd_barrier_post(unsigned* bar, volatile LAS unsigned* st) {
  XcdBarrier b; b.bar = bar; b.x = xb_xcc_id(); b.st = st;
  if (threadIdx.x == 0) (void)xb_add(&bar[XB_XCNT(b.x)], 1u);
  return b;
}
DI void xcd_barrier_complete(unsigned* bar, unsigned x, unsigned& nloc, unsigned& nx) {
  const unsigned G = gridDim.x * gridDim.y * gridDim.z;
  unsigned sum, cnt, mine, sp = 0u;
  for (;;) {
    sum = 0u; cnt = 0u; mine = 0u;
#pragma unroll
    for (unsigned j = 0; j < 16; ++j) { const unsigned c = xb_ld(&bar[XB_XCNT(j)]); sum += c; cnt += (c > 0u) ? 1u : 0u; mine = (j == x) ? c : mine; }
    if (sum == G) break;
    __builtin_amdgcn_s_sleep(1);
    if ((++sp & 255u) == 0u) { if (xb_ld(&bar[XB_TMO])) break; if (sp > XB_SPIN_CAP) { atomicAdd(&bar[XB_TMO], 1u); break; } }
  }
  nloc = mine > 0u ? mine : 1u; nx = cnt > 0u ? cnt : 1u;
}
DI void xcd_barrier(const XcdBarrier& b) {
  asm volatile("s_waitcnt vmcnt(0)" ::: "memory");
  __syncthreads();
  if (threadIdx.x == 0) {
    unsigned* bar = b.bar;
    __builtin_amdgcn_s_waitcnt(0);
    unsigned nloc = b.st[0], nx = b.st[1];
    if (nloc == 0u) { xcd_barrier_complete(bar, b.x, nloc, nx); b.st[0] = nloc; b.st[1] = nx; }
    const unsigned old = xb_add(&bar[XB_XSUB(b.x)], 1u);
    const unsigned gen = old / nloc;
    if (old + 1u == (gen + 1u) * nloc) {
      __builtin_amdgcn_fence(__ATOMIC_RELEASE, "agent");
      asm volatile("s_waitcnt vmcnt(0)" ::: "memory");
      const unsigned og = xb_add(&bar[XB_TOP], 1u);
      const unsigned tg = og / nx;
      if (og + 1u == (tg + 1u) * nx) xb_add(&bar[XB_TOPGEN], 1u);
      else XB_SPIN(xb_ld(&bar[XB_TOPGEN]) == tg, bar);
      __builtin_amdgcn_fence(__ATOMIC_ACQUIRE, "agent");
      xb_add(&bar[XB_XGEN(b.x)], 1u);
      asm volatile("s_waitcnt vmcnt(0)" ::: "memory");
    } else {
      XB_SPIN(xb_ld(&bar[XB_XGEN(b.x)]) == gen, bar);
      __builtin_amdgcn_fence(__ATOMIC_ACQUIRE, "agent");
      asm volatile("s_waitcnt vmcnt(0)" ::: "memory");
    }
  }
  __syncthreads();
}

DI void run_phase(const Params& P, int ph, char* smem) {
  ushort_t* P8 = P.bufA;
  ushort_t* wb = P.bufB;
  switch (ph) {
    case 0: phase_prep(P, smem); break;
    case 1: phase_in(P, smem); break;
    case 2: phase_lru(P, smem); break;
    case 3: phase_resid_gemm<false>(P.bufC, P.Wt_out, nullptr, P.hb0, P.hb0, P.ssA, smem); break;
    case 4: phase_route(P, 0, P.hb0, P.ssA, smem); break;
    case 5: phase_expert_u(P, 0, P.hb0, P8); break;
    case 6: phase_expert_combine(P, P8, wb, P.ssA); break;
    case 7: phase_expert_v(P, 0, P.hb0, wb, P.ssA, P.ssB); break;
    case 8: phase_ple(P, 0, P.hb0, P.hb1, P.ssB, P.ssA, smem); break;
    case 9: phase_kvq(P, P.hb1, P.ssA, smem); break;
    case 10: phase_attn(P, smem); break;
    case 11: phase_resid_gemm<false>(P.bufC, P.Wt_o, nullptr, P.hb1, P.hb1, P.ssB, smem); break;
    case 12: phase_route(P, 1, P.hb1, P.ssB, smem); break;
    case 13: phase_expert_u(P, 1, P.hb1, P8); break;
    case 14: phase_expert_combine(P, P8, wb, P.ssB); break;
    case 15: phase_expert_v(P, 1, P.hb1, wb, P.ssB, P.ssA); break;
    case 16: phase_ple(P, 1, P.hb1, P.hb0, P.ssA, P.ssB, smem); break;
    case 17: phase_final(P, P.hb0, P.ssB); break;
    default: break;
  }
}

#if MEGA
__global__ void __launch_bounds__(NTHR, 2) mega_kernel(Params P) {
  __shared__ __attribute__((aligned(16))) char smem[SMEM_BYTES];
  __shared__ uint4 xb_words;
  if (threadIdx.x == 0) xb_words = make_uint4(0u, 0u, 0u, 0u);
  __syncthreads();
  XcdBarrier xb = xcd_barrier_post(P.bar, (volatile LAS unsigned*)&xb_words);
  if (P.bar == nullptr) cg::this_grid().sync();
#define PH_(n) run_phase(P, n, smem); xcd_barrier(xb);
  PH_(0) PH_(1) PH_(2) PH_(3) PH_(4) PH_(5) PH_(6) PH_(7) PH_(8) PH_(9) PH_(10) PH_(11) PH_(12) PH_(13) PH_(14) PH_(15) PH_(16)
#undef PH_
  run_phase(P, 17, smem);
}
#else
template <int PH>
__global__ void __launch_bounds__(NTHR, 2) phase_kernel(Params P) {
  __shared__ __attribute__((aligned(16))) char smem[SMEM_BYTES];
  run_phase(P, PH, smem);
}
template <int PH> static void launch_phases(const Params& P, hipStream_t stream) {
  phase_kernel<PH><<<512, NTHR, 0, stream>>>(P);
  if constexpr (PH + 1 < 18) launch_phases<PH + 1>(P, stream);
}
#endif

extern "C" void kernel_launch(void* const* d_in, const int* in_sizes, int n_in, void* d_out, int out_size, void* d_ws,
                              size_t ws_size, hipStream_t stream) {
  Params P{};
  const float** fp = (const float**)&P;
  for (int i = 0; i < 25; ++i) fp[i] = (const float*)d_in[i];
  P.h = (float*)d_out;
  char* ws = (char*)d_ws;
  const size_t MB = 1024 * 1024;
  size_t off = 0;
  auto take = [&](size_t bytes) { char* p = ws + off; off += (bytes + 255) & ~(size_t)255; return p; };
  P.Wt_in = (ushort_t*)take(4 * MB); P.Wt_out = (ushort_t*)take(2 * MB); P.Wt_kvq = (ushort_t*)take(6 * MB);
  P.Wt_o = (ushort_t*)take(2 * MB); P.Wt_pq = (ushort_t*)take(8 * MB); P.Wt_gate = (ushort_t*)take(4 * MB);
  P.Wt_proj = (ushort_t*)take(1 * MB); P.Wt_r = (ushort_t*)take(256 * 1024); P.Wt_i = (ushort_t*)take(256 * 1024);
  P.SK = (ushort_t*)take(1 * MB);
  P.Ub8 = (unsigned char*)take(32 * MB); P.Vb8 = (unsigned char*)take(32 * MB); P.pb = (ushort_t*)take(32 * MB);
  P.hb0 = (ushort_t*)take(64 * MB); P.hb1 = (ushort_t*)take(64 * MB);
  P.bufA = (ushort_t*)take(64 * MB); P.bufB = (ushort_t*)take(64 * MB); P.bufC = (ushort_t*)take(64 * MB);
  P.eidx = (ushort_t*)take(8 * MB); P.gw = (float*)take(16 * MB);
  P.ssA = (float*)take(1 * MB); P.ssB = (float*)take(1 * MB);
  P.bar = (unsigned*)take(64 * 1024);
  if (off > ws_size) { fprintf(stderr, "workspace too small: need %zu have %zu\n", off, ws_size); return; }
#if MEGA
  static int grid_blocks = 0;
  if (!grid_blocks) {
    int dev = 0, cus = 0, per_cu = 0;
    hipGetDevice(&dev);
    hipDeviceGetAttribute(&cus, hipDeviceAttributeMultiprocessorCount, dev);
    hipOccupancyMaxActiveBlocksPerMultiprocessor(&per_cu, mega_kernel, NTHR, 0);
    if (per_cu > 2) per_cu = 2;
    if (per_cu < 1) per_cu = 1;
    grid_blocks = cus * per_cu;
  }
  void* args[] = {&P};
  hipMemsetAsync(P.bar, 0, XCD_BAR_WORDS * sizeof(unsigned), stream);
  hipError_t e = hipLaunchCooperativeKernel((void*)mega_kernel, dim3(grid_blocks), dim3(NTHR), args, 0, stream);
  if (e != hipSuccess) fprintf(stderr, "cooperative launch failed: %s (grid %d)\n", hipGetErrorString(e), grid_blocks);
#else
  launch_phases<0>(P, stream);
#endif
}
```

```cpp
#include <hip/hip_runtime.h>
#include <hip/hip_cooperative_groups.h>
#include <cstdio>
#include <cstdint>
namespace cg = cooperative_groups;

#ifndef MEGA
#define MEGA 1
#endif

#define DI __device__ __forceinline__
typedef unsigned short ushort_t;
typedef short bf16x8 __attribute__((ext_vector_type(8)));
typedef float f32x16 __attribute__((ext_vector_type(16)));
typedef float f32x2_t __attribute__((ext_vector_type(2)));
typedef __bf16 bf16x2_t __attribute__((ext_vector_type(2)));
typedef float f32x2 __attribute__((ext_vector_type(2)));

constexpr int T_ = 32768, D_ = 1024, S_ = 2048;
constexpr int NTHR = 256;
constexpr int SMEM_BYTES = 73728 + 2048;
constexpr int XTRA_OFF = 73728;

struct Params {
  const float *x, *p, *norm_mix, *a_w_in, *a_conv_w, *a_conv_b, *a_w_r, *a_w_i, *a_b_r, *a_b_i, *a_lambda, *a_w_out,
      *kv_norm, *w_kv, *b_w_q, *b_w_o, *norm_ffn, *peer_w_q, *peer_sub_keys, *peer_u, *peer_v, *norm_ple, *ple_w_gate,
      *ple_w_proj, *final_norm;
  float* h;
  ushort_t *Wt_in, *Wt_out, *Wt_kvq, *Wt_o, *Wt_pq, *Wt_gate, *Wt_proj, *Wt_r, *Wt_i, *SK;
  unsigned char *Ub8, *Vb8; ushort_t *pb, *hb0, *hb1, *bufA, *bufB, *bufC, *eidx;
  float *gw, *ssA, *ssB;
  unsigned* bar;
};

DI unsigned pk2(float lo, float hi) { f32x2_t v = {lo, hi}; bf16x2_t b = __builtin_convertvector(v, bf16x2_t); return __builtin_bit_cast(unsigned, b); }
DI ushort_t f2bf(float x) { return (ushort_t)(pk2(x, 0.f) & 0xffffu); }
DI float bf_lo(unsigned u) { return __uint_as_float(u << 16); }
DI float bf_hi(unsigned u) { return __uint_as_float(u & 0xffff0000u); }
DI float bf2f(ushort_t u) { return __uint_as_float(((unsigned)u) << 16); }
DI float sigmoidf_(float x) { return __builtin_amdgcn_rcpf(1.f + __expf(-x)); }
DI float gelu_tanh(float x) { float u = 1.5957691216057308f * (x + 0.044715f * x * x * x); return x * __builtin_amdgcn_rcpf(1.f + __expf(-u)); }
DI f32x16 mfma32(bf16x8 a, bf16x8 b, f32x16 c) { return __builtin_amdgcn_mfma_f32_32x32x16_bf16(a, b, c, 0, 0, 0); }
DI f32x16 zero16() { f32x16 z; for (int i = 0; i < 16; ++i) z[i] = 0.f; return z; }
DI int otid() { int t = threadIdx.x; asm volatile("" : "+v"(t)); return t; }
DI int obid() { int b = blockIdx.x; asm volatile("" : "+s"(b)); return b; }
DI float dpp_x1(float x) { return __int_as_float(__builtin_amdgcn_update_dpp(0, __float_as_int(x), 0xB1, 0xF, 0xF, false)); }
DI float dpp_x2(float x) { return __int_as_float(__builtin_amdgcn_update_dpp(0, __float_as_int(x), 0x4E, 0xF, 0xF, false)); }
DI float dpp_x4(float x) {
  int t = __builtin_amdgcn_update_dpp(0, __float_as_int(x), 0x104, 0xF, 0x5, false);
  t = __builtin_amdgcn_update_dpp(t, __float_as_int(x), 0x114, 0xF, 0xA, false);
  return __int_as_float(t);
}
DI float dpp_x8(float x) { return __int_as_float(__builtin_amdgcn_update_dpp(0, __float_as_int(x), 0x128, 0xF, 0xF, false)); }
DI float swap_add32(float a, float b) { const auto r = __builtin_amdgcn_permlane32_swap(__float_as_uint(a), __float_as_uint(b), false, false); return __uint_as_float(r[0]) + __uint_as_float(r[1]); }
DI float swap_add16(float a, float b) { const auto r = __builtin_amdgcn_permlane16_swap(__float_as_uint(a), __float_as_uint(b), false, false); return __uint_as_float(r[0]) + __uint_as_float(r[1]); }
DI float plx32(float x, bool upper) { const auto r = __builtin_amdgcn_permlane32_swap(__float_as_uint(x), __float_as_uint(x), false, false); return __uint_as_float(upper ? r[0] : r[1]); }
DI float plx16(float x, bool odd) { const auto r = __builtin_amdgcn_permlane16_swap(__float_as_uint(x), __float_as_uint(x), false, false); return __uint_as_float(odd ? r[0] : r[1]); }
DI int crow(int reg, int h) { return (reg & 3) + 8 * (reg >> 2) + 4 * h; }

DI void tconv(const float* __restrict__ W, const float* __restrict__ g, ushort_t* __restrict__ Wt, int K, int N, int nb,
              int& base, char* smem) {
  float* tile = (float*)smem;
  const int tid = otid(), G = gridDim.x;
  const int tk = K / 64, tn = N / 64, count = nb * tk * tn;
  int start = (obid() - (base % G) + G) % G;
  for (int t = start; t < count; t += G) {
    const int b = t / (tk * tn), rem = t % (tk * tn), kt = rem / tn, nt = rem % tn;
    const float* src = W + (size_t)b * K * N + (size_t)(kt * 64) * N + nt * 64;
    __syncthreads();
    {
      const int ty = tid >> 4, tx = tid & 15;
#pragma unroll
      for (int i = 0; i < 4; ++i) {
        const int kr = ty + 16 * i;
        float4 v = *(const float4*)(src + (size_t)kr * N + tx * 4);
        const float gs = g ? g[kt * 64 + kr] : 1.f;
        tile[kr * 65 + tx * 4 + 0] = v.x * gs; tile[kr * 65 + tx * 4 + 1] = v.y * gs;
        tile[kr * 65 + tx * 4 + 2] = v.z * gs; tile[kr * 65 + tx * 4 + 3] = v.w * gs;
      }
    }
    __syncthreads();
    {
      const int n = tid >> 2, kc = tid & 3;
      unsigned o[8];
#pragma unroll
      for (int i = 0; i < 8; ++i) o[i] = pk2(tile[(kc * 16 + 2 * i) * 65 + n], tile[(kc * 16 + 2 * i + 1) * 65 + n]);
      ushort_t* dst = Wt + (size_t)b * K * N + (size_t)(nt * 64 + n) * K + kt * 64 + kc * 16;
      *(uint4*)dst = make_uint4(o[0], o[1], o[2], o[3]);
      *(uint4*)(dst + 8) = make_uint4(o[4], o[5], o[6], o[7]);
    }
  }
  base += count;
}

DI void econv(const float* __restrict__ src, const float* __restrict__ g, ushort_t* __restrict__ dst, size_t n8) {
  const size_t stride = (size_t)gridDim.x * NTHR;
  for (size_t i = (size_t)obid() * NTHR + otid(); i < n8; i += stride) {
    float4 a = *(const float4*)(src + i * 8), b = *(const float4*)(src + i * 8 + 4);
    if (g) {
      const int c = (int)((i * 8) & 1023);
      float4 ga = *(const float4*)(g + c), gb = *(const float4*)(g + c + 4);
      a.x *= ga.x; a.y *= ga.y; a.z *= ga.z; a.w *= ga.w; b.x *= gb.x; b.y *= gb.y; b.z *= gb.z; b.w *= gb.w;
    }
    *(uint4*)(dst + i * 8) = make_uint4(pk2(a.x, a.y), pk2(a.z, a.w), pk2(b.x, b.y), pk2(b.z, b.w));
  }
}

constexpr float U_SCALE = 128.f, V_SCALE = 32.f;
DI void econv8(const float* __restrict__ src, const float* __restrict__ g, unsigned char* __restrict__ dst, size_t n16, float scale) {
  const size_t stride = (size_t)gridDim.x * NTHR;
  for (size_t i = (size_t)obid() * NTHR + otid(); i < n16; i += stride) {
    unsigned o[4];
#pragma unroll
    for (int q = 0; q < 4; ++q) {
      float4 a = *(const float4*)(src + i * 16 + q * 4);
      if (g) { const float4 ga = *(const float4*)(g + ((i * 16 + q * 4) & 1023)); a.x *= ga.x; a.y *= ga.y; a.z *= ga.z; a.w *= ga.w; }
      int v = 0;
      v = __builtin_amdgcn_cvt_pk_fp8_f32(a.x * scale, a.y * scale, v, false);
      v = __builtin_amdgcn_cvt_pk_fp8_f32(a.z * scale, a.w * scale, v, true);
      o[q] = (unsigned)v;
    }
    *(uint4*)(dst + i * 16) = make_uint4(o[0], o[1], o[2], o[3]);
  }
}

DI void conv_tables(const Params& P, int layer) {
  econv8(P.peer_u + (size_t)layer * 16384 * 1024, P.norm_ffn + layer * 1024, P.Ub8 + (size_t)layer * 16384 * 1024, (size_t)16384 * 1024 / 16, U_SCALE);
  econv8(P.peer_v + (size_t)layer * 16384 * 1024, nullptr, P.Vb8 + (size_t)layer * 16384 * 1024, (size_t)16384 * 1024 / 16, V_SCALE);
}

DI void phase_prep(const Params& P, char* smem) {
  int base = 0;
  tconv(P.a_w_in, P.norm_mix, P.Wt_in, 1024, 2048, 1, base, smem);
  tconv(P.a_w_r, nullptr, P.Wt_r, 128, 128, 8, base, smem);
  tconv(P.a_w_i, nullptr, P.Wt_i, 128, 128, 8, base, smem);
  tconv(P.a_w_out, nullptr, P.Wt_out, 1024, 1024, 1, base, smem);
  tconv(P.w_kv, P.kv_norm, P.Wt_kvq, 1024, 2048, 1, base, smem);
  tconv(P.b_w_q, P.norm_mix + 1024, P.Wt_kvq + (size_t)2048 * 1024, 1024, 1024, 1, base, smem);
  tconv(P.b_w_o, nullptr, P.Wt_o, 1024, 1024, 1, base, smem);
  for (int l = 0; l < 2; ++l) {
    tconv(P.peer_w_q + (size_t)l * 1024 * 2048, P.norm_ffn + l * 1024, P.Wt_pq + (size_t)l * 2048 * 1024, 1024, 2048, 1, base, smem);
    tconv(P.ple_w_gate + (size_t)l * 1024 * 1024, P.norm_ple + l * 1024, P.Wt_gate + (size_t)l * 1024 * 1024, 1024, 1024, 1, base, smem);
    tconv(P.ple_w_proj + (size_t)l * 256 * 1024, nullptr, P.Wt_proj + (size_t)l * 256 * 1024, 256, 1024, 1, base, smem);
  }
  econv(P.peer_sub_keys, nullptr, P.SK, (size_t)2 * 8 * 2 * 128 * 128 / 8);
  conv_tables(P, 0);
  conv_tables(P, 1);
  econv(P.p, nullptr, P.pb, (size_t)2 * T_ * 256 / 8);
  {
    const size_t n8 = (size_t)T_ * 1024 / 8, stride = (size_t)gridDim.x * NTHR;
    for (size_t i = (size_t)obid() * NTHR + otid(); i < n8; i += stride) {
      float4 a = *(const float4*)(P.x + i * 8), b = *(const float4*)(P.x + i * 8 + 4);
      *(uint4*)(P.hb0 + i * 8) = make_uint4(pk2(a.x, a.y), pk2(a.z, a.w), pk2(b.x, b.y), pk2(b.z, b.w));
      float s = a.x * a.x + a.y * a.y + a.z * a.z + a.w * a.w + b.x * b.x + b.y * b.y + b.z * b.z + b.w * b.w;
      s += dpp_x1(s); s += dpp_x2(s); s += dpp_x4(s); s += dpp_x8(s);
      if ((otid() & 15) == 0) P.ssA[i >> 4] = s;
    }
  }
}

constexpr int GEMM_BUF = 2 * 128 * 128;
constexpr int GEMM_SMEM = 2 * GEMM_BUF;
DI void glds16(const void* gsrc, unsigned lds_dst) {
  unsigned keep;
  asm volatile("s_mov_b32 %0, m0\n\ts_mov_b32 m0, %2\n\ts_nop 0\n\tglobal_load_lds_dwordx4 %1, off\n\ts_mov_b32 m0, %0"
               : "=&s"(keep) : "v"(gsrc), "s"(lds_dst) : "memory");
}
DI void gemm_mainloop(const ushort_t* __restrict__ A, int lda, const ushort_t* __restrict__ Bt, int ldb, int K,
                      f32x16 (&acc)[2][2], char* smem) {
  const int tid = otid(), lane = tid & 63, w = tid >> 6, wm = w >> 1, wn = w & 1, r = lane & 31, h = lane >> 5;
  const unsigned lds0 = (unsigned)(size_t)smem;
  const int drow = w * 32 + (lane >> 3);
  const ushort_t* ga[4]; const ushort_t* gb[4];
#pragma unroll
  for (int q = 0; q < 4; ++q) {
    const int row = drow + q * 8;
    const int kc = (lane & 7) ^ ((row >> 1) & 7);
    ga[q] = A + (size_t)row * lda + kc * 8;
    gb[q] = Bt + (size_t)row * ldb + kc * 8;
  }
  const unsigned dstw = (unsigned)__builtin_amdgcn_readfirstlane((int)(lds0 + (unsigned)(w * 32) * 128u));
#define G_DMA(buf, koff) { _Pragma("unroll") for (int q = 0; q < 4; ++q) { \
      glds16(ga[q] + (koff), dstw + (unsigned)((buf) * GEMM_BUF + q * 1024)); \
      glds16(gb[q] + (koff), dstw + (unsigned)((buf) * GEMM_BUF + 16384 + q * 1024)); } }
  unsigned offA[2][4], offB[2][4];
#pragma unroll
  for (int i = 0; i < 2; ++i)
#pragma unroll
    for (int kk = 0; kk < 4; ++kk) {
      const int ra_ = wm * 64 + i * 32 + r, rb_ = wn * 64 + i * 32 + r, kc = kk * 2 + h;
      offA[i][kk] = (unsigned)(ra_ * 128 + ((kc ^ ((ra_ >> 1) & 7)) * 16));
      offB[i][kk] = (unsigned)(16384 + rb_ * 128 + ((kc ^ ((rb_ >> 1) & 7)) * 16));
    }
  const int nk = K >> 6;
  __syncthreads();
  G_DMA(0, 0);
  asm volatile("s_waitcnt vmcnt(0)" ::: "memory");
  __syncthreads();
  for (int it = 0; it < nk; ++it) {
    const int buf = it & 1;
    if (it + 1 < nk) G_DMA(buf ^ 1, (it + 1) * 64);
    const char* st = smem + buf * GEMM_BUF;
#pragma unroll
    for (int kk = 0; kk < 4; ++kk) {
      const bf16x8 a0 = *(const bf16x8*)(st + offA[0][kk]);
      const bf16x8 a1 = *(const bf16x8*)(st + offA[1][kk]);
      const bf16x8 b0 = *(const bf16x8*)(st + offB[0][kk]);
      const bf16x8 b1 = *(const bf16x8*)(st + offB[1][kk]);
      acc[0][0] = mfma32(a0, b0, acc[0][0]); acc[0][1] = mfma32(a0, b1, acc[0][1]);
      acc[1][0] = mfma32(a1, b0, acc[1][0]); acc[1][1] = mfma32(a1, b1, acc[1][1]);
    }
    asm volatile("s_waitcnt vmcnt(0)" ::: "memory");
    __syncthreads();
  }
#undef G_DMA
}

constexpr int WST = 24576;
DI void gemm_mainloop_w(const ushort_t* __restrict__ A, int lda, const ushort_t* __restrict__ Bt, int ldb, int K,
                        f32x16 (&acc)[2][4], char* smem) {
  const int tid = otid(), lane = tid & 63, w = tid >> 6, wm = w >> 1, wn = w & 1, r = lane & 31, h = lane >> 5;
  const unsigned lds0 = (unsigned)(size_t)smem;
  const ushort_t* ga[2]; const ushort_t* gb[4];
#pragma unroll
  for (int q = 0; q < 2; ++q) {
    const int row = (2 * w + q) * 16 + (lane >> 2);
    ga[q] = A + (size_t)row * lda + (((lane & 3) ^ ((row >> 2) & 3)) * 8);
  }
#pragma unroll
  for (int q = 0; q < 4; ++q) {
    const int row = (4 * w + q) * 16 + (lane >> 2);
    gb[q] = Bt + (size_t)row * ldb + (((lane & 3) ^ ((row >> 2) & 3)) * 8);
  }
  const unsigned dsta = (unsigned)__builtin_amdgcn_readfirstlane((int)(lds0 + (unsigned)(2 * w) * 1024u));
  const unsigned dstb = (unsigned)__builtin_amdgcn_readfirstlane((int)(lds0 + 8192u + (unsigned)(4 * w) * 1024u));
#define GW_DMA(stg, koff) { _Pragma("unroll") for (int q = 0; q < 2; ++q) glds16(ga[q] + (koff), dsta + (unsigned)((stg) * WST + q * 1024)); \
    _Pragma("unroll") for (int q = 0; q < 4; ++q) glds16(gb[q] + (koff), dstb + (unsigned)((stg) * WST + q * 1024)); }
  unsigned offA[2][2], offB[4][2];
#pragma unroll
  for (int kk = 0; kk < 2; ++kk) {
    const int kc = kk * 2 + h;
#pragma unroll
    for (int i = 0; i < 2; ++i) { const int ra_ = wm * 64 + i * 32 + r; offA[i][kk] = (unsigned)(ra_ * 64 + ((kc ^ ((ra_ >> 2) & 3)) * 16)); }
#pragma unroll
    for (int j = 0; j < 4; ++j) { const int rb_ = wn * 128 + j * 32 + r; offB[j][kk] = (unsigned)(8192 + rb_ * 64 + ((kc ^ ((rb_ >> 2) & 3)) * 16)); }
  }
  const int nk = K >> 5;
  __syncthreads();
  GW_DMA(0, 0);
  asm volatile("s_waitcnt vmcnt(0)" ::: "memory");
  __syncthreads();
  for (int it = 0; it < nk; ++it) {
    const int buf = it & 1;
    if (it + 1 < nk) GW_DMA(buf ^ 1, (it + 1) * 32);
    const char* st = smem + buf * WST;
    __builtin_amdgcn_s_setprio(1);
#pragma unroll
    for (int kk = 0; kk < 2; ++kk) {
      const bf16x8 a0 = *(const bf16x8*)(st + offA[0][kk]);
      const bf16x8 a1 = *(const bf16x8*)(st + offA[1][kk]);
#pragma unroll
      for (int j = 0; j < 4; ++j) {
        const bf16x8 bj = *(const bf16x8*)(st + offB[j][kk]);
        acc[0][j] = mfma32(a0, bj, acc[0][j]);
        acc[1][j] = mfma32(a1, bj, acc[1][j]);
      }
    }
    __builtin_amdgcn_s_setprio(0);
    asm volatile("s_waitcnt vmcnt(0)" ::: "memory");
    __syncthreads();
  }
#undef GW_DMA
}

DI void tile_rowsumsq_w(const f32x16 (&v)[2][4], float* red, float* __restrict__ ss_out, int m0, int nt) {
  const int tid = otid(), lane = tid & 63, w = tid >> 6, wm = w >> 1, wn = w & 1, r = lane & 31, h = lane >> 5;
  __syncthreads();
#pragma unroll
  for (int i = 0; i < 2; ++i)
#pragma unroll
    for (int reg = 0; reg < 16; ++reg) {
      float s = v[i][0][reg] * v[i][0][reg] + v[i][1][reg] * v[i][1][reg] + v[i][2][reg] * v[i][2][reg] + v[i][3][reg] * v[i][3][reg];
      s += dpp_x1(s); s += dpp_x2(s); s += dpp_x4(s); s += dpp_x8(s); s = swap_add16(s, s);
      if (r == 0) red[wn * 128 + wm * 64 + i * 32 + crow(reg, h)] = s;
    }
  __syncthreads();
  if (tid < 128) *(float2*)(ss_out + (size_t)(m0 + tid) * 8 + 2 * nt) = make_float2(red[tid] + red[128 + tid], 0.f);
}

#define TILE_LOOP(t, tiles) for (int slot_ = (obid() >> 3), per_ = (tiles) >> 3, t = (obid() & 7) * per_ + slot_; slot_ < per_; slot_ += (int)(gridDim.x >> 3), t += (int)(gridDim.x >> 3))

DI float rstd_of(const float* __restrict__ ss, int row) {
  const float4 a = *(const float4*)(ss + (size_t)row * 8), b = *(const float4*)(ss + (size_t)row * 8 + 4);
  return rsqrtf((a.x + a.y + a.z + a.w + b.x + b.y + b.z + b.w) * (1.f / 1024.f) + 1e-6f);
}

DI void tile_rowsumsq(const f32x16 (&v)[2][2], float* red, float* __restrict__ ss_out, int m0, int nt) {
  const int tid = otid(), lane = tid & 63, w = tid >> 6, wm = w >> 1, wn = w & 1, r = lane & 31, h = lane >> 5;
  __syncthreads();
#pragma unroll
  for (int i = 0; i < 2; ++i)
#pragma unroll
    for (int reg = 0; reg < 16; ++reg) {
      float s = v[i][0][reg] * v[i][0][reg] + v[i][1][reg] * v[i][1][reg];
      s += dpp_x1(s); s += dpp_x2(s); s += dpp_x4(s); s += dpp_x8(s); s = swap_add16(s, s);
      if (r == 0) red[wn * 128 + wm * 64 + i * 32 + crow(reg, h)] = s;
    }
  __syncthreads();
  if (tid < 128) ss_out[(size_t)(m0 + tid) * 8 + nt] = red[tid] + red[128 + tid];
}

#define EPI_LOOP(i, j, reg) _Pragma("unroll") for (int i = 0; i < 2; ++i) _Pragma("unroll") for (int j = 0; j < 2; ++j) _Pragma("unroll") for (int reg = 0; reg < 16; ++reg)

DI void phase_in(const Params& P, char* smem) {
  const int tid = otid(), lane = tid & 63, w = tid >> 6, wm = w >> 1, wn = w & 1, r = lane & 31, h = lane >> 5;
  const int NT = 8, tiles = (T_ / 128) * NT;
  TILE_LOOP(t, tiles) {
    const int mt = t / NT, nt = t % NT, m0 = mt * 128, n0 = nt * 256;
    f32x16 acc[2][4];
#pragma unroll
    for (int i = 0; i < 2; ++i)
#pragma unroll
      for (int j = 0; j < 4; ++j) acc[i][j] = zero16();
    float* rs_s = (float*)(smem + XTRA_OFF);
    const float myrs = (tid < 128) ? rstd_of(P.ssA, m0 + tid) : 0.f;
    gemm_mainloop_w(P.hb0 + (size_t)m0 * 1024, 1024, P.Wt_in + (size_t)n0 * 1024, 1024, 1024, acc, smem);
    if (tid < 128) rs_s[tid] = myrs;
    __syncthreads();
    ushort_t* dst = (nt < 4) ? (P.bufA + n0) : (P.bufB + n0 - 1024);
#pragma unroll
    for (int i = 0; i < 2; ++i)
#pragma unroll
      for (int reg = 0; reg < 16; ++reg) {
        const int rl = wm * 64 + i * 32 + crow(reg, h);
        const float rs = rs_s[rl];
#pragma unroll
        for (int j = 0; j < 4; ++j) {
          const int cl = wn * 128 + j * 32 + r;
          float v = acc[i][j][reg] * rs;
          if (nt < 4) v = gelu_tanh(v);
          dst[(size_t)(m0 + rl) * 1024 + cl] = f2bf(v);
        }
      }
  }
}

template <bool F32RES>
DI void phase_resid_gemm(const ushort_t* __restrict__ A, const ushort_t* __restrict__ Bt, const float* resid_f,
                         const ushort_t* resid_b, ushort_t* hb, float* __restrict__ ss, char* smem) {
  const int tid = otid(), lane = tid & 63, w = tid >> 6, wm = w >> 1, wn = w & 1, r = lane & 31, h = lane >> 5;
  float* red = (float*)(smem + XTRA_OFF + 512);
  const int NT = 4, tiles = (T_ / 128) * NT;
  TILE_LOOP(t, tiles) {
    const int mt = t / NT, nt = t % NT, m0 = mt * 128, n0 = nt * 256;
    f32x16 acc[2][4];
#pragma unroll
    for (int i = 0; i < 2; ++i)
#pragma unroll
      for (int j = 0; j < 4; ++j) acc[i][j] = zero16();
    gemm_mainloop_w(A + (size_t)m0 * 1024, 1024, Bt + (size_t)n0 * 1024, 1024, 1024, acc, smem);
#pragma unroll
    for (int i = 0; i < 2; ++i)
#pragma unroll
      for (int reg = 0; reg < 16; ++reg) {
        const int rl = wm * 64 + i * 32 + crow(reg, h);
        const unsigned off = (unsigned)(m0 + rl) * 1024u + (unsigned)(n0 + wn * 128 + r);
        ushort_t* bp = hb + off;
        float sq = 0.f;
#pragma unroll
        for (int j = 0; j < 4; ++j) {
          const float v = acc[i][j][reg] + (F32RES ? resid_f[off + j * 32] : bf2f(resid_b[off + j * 32]));
          bp[j * 32] = f2bf(v);
          sq += v * v;
        }
        sq += dpp_x1(sq); sq += dpp_x2(sq); sq += dpp_x4(sq); sq += dpp_x8(sq); sq = swap_add16(sq, sq);
        if (r == 0) red[wn * 128 + rl] = sq;
        if ((reg & 3) == 3) __builtin_amdgcn_sched_barrier(0);
      }
    __syncthreads();
    if (tid < 128) *(float2*)(ss + (size_t)(m0 + tid) * 8 + 2 * nt) = make_float2(red[tid] + red[128 + tid], 0.f);
  }
}

DI void phase_ple(const Params& P, int layer, const ushort_t* __restrict__ hb_in, ushort_t* __restrict__ hb_out,
                  const float* __restrict__ ss_in, float* __restrict__ ss_out, char* smem) {
  const int tid = otid(), lane = tid & 63, w = tid >> 6, wm = w >> 1, wn = w & 1, r = lane & 31, h = lane >> 5;
  float* red = (float*)(smem + XTRA_OFF + 512);
  const ushort_t* Wg = P.Wt_gate + (size_t)layer * 1024 * 1024;
  const ushort_t* Wp = P.Wt_proj + (size_t)layer * 256 * 1024;
  const ushort_t* pb = P.pb + (size_t)layer * T_ * 256;
  const int NT = 8, tiles = (T_ / 128) * NT;
  TILE_LOOP(t, tiles) {
    const int mt = t / NT, nt = t % NT, m0 = mt * 128, n0 = nt * 128;
    f32x16 acc[2][2], acc2[2][2];
    for (int i = 0; i < 2; ++i) for (int j = 0; j < 2; ++j) { acc[i][j] = zero16(); acc2[i][j] = zero16(); }
    float* rs_s = (float*)(smem + XTRA_OFF);
    const float myrs = (tid < 128) ? rstd_of(ss_in, m0 + tid) : 0.f;
    gemm_mainloop(hb_in + (size_t)m0 * 1024, 1024, Wg + (size_t)n0 * 1024, 1024, 1024, acc, smem);
    gemm_mainloop(pb + (size_t)m0 * 256, 256, Wp + (size_t)n0 * 256, 256, 256, acc2, smem);
    if (tid < 128) rs_s[tid] = myrs;
    __syncthreads();
#pragma unroll
    for (int i = 0; i < 2; ++i)
#pragma unroll
      for (int reg = 0; reg < 16; ++reg) {
        const int row = m0 + wm * 64 + i * 32 + crow(reg, h);
        const float rs = rs_s[row - m0];
#pragma unroll
        for (int j = 0; j < 2; ++j) {
          const int col = n0 + wn * 64 + j * 32 + r;
          const float gate = sigmoidf_(acc[i][j][reg] * rs);
          const float v = bf2f(hb_in[(size_t)row * 1024 + col]) + gate * acc2[i][j][reg];
          acc[i][j][reg] = v;
          hb_out[(size_t)row * 1024 + col] = f2bf(v);
        }
      }
    tile_rowsumsq(acc, red, ss_out, m0, nt);
  }
}

DI void phase_kvq(const Params& P, const ushort_t* __restrict__ hb_in, const float* __restrict__ ss_in, char* smem) {
  const int tid = otid(), lane = tid & 63, w = tid >> 6, wm = w >> 1, wn = w & 1, r = lane & 31, h = lane >> 5;
  const int NT = 12, tiles = (T_ / 128) * NT;
  TILE_LOOP(t, tiles) {
    const int mt = t / NT, nt = t % NT, m0 = mt * 128, n0 = nt * 256;
    f32x16 acc[2][4];
#pragma unroll
    for (int i = 0; i < 2; ++i)
#pragma unroll
      for (int j = 0; j < 4; ++j) acc[i][j] = zero16();
    float* rs_s = (float*)(smem + XTRA_OFF);
    const float myrs = (tid < 128) ? rstd_of(ss_in, m0 + tid) : 0.f;
    gemm_mainloop_w(hb_in + (size_t)m0 * 1024, 1024, P.Wt_kvq + (size_t)n0 * 1024, 1024, 1024, acc, smem);
    if (tid < 128) rs_s[tid] = myrs;
    __syncthreads();
    if (nt >= 4 && nt < 8) {
      constexpr int TS = 136;
      ushort_t* sT = (ushort_t*)smem;
#pragma unroll
      for (int i = 0; i < 2; ++i)
#pragma unroll
        for (int q4 = 0; q4 < 4; ++q4) {
          const int sl = wm * 64 + i * 32 + 8 * q4 + 4 * h;
          const float r0 = rs_s[sl], r1 = rs_s[sl + 1], r2 = rs_s[sl + 2], r3 = rs_s[sl + 3];
#pragma unroll
          for (int j = 0; j < 4; ++j) {
            const int d = wn * 128 + j * 32 + r;
            *(uint2*)(sT + d * TS + sl) = make_uint2(pk2(acc[i][j][q4 * 4 + 0] * r0, acc[i][j][q4 * 4 + 1] * r1),
                                                     pk2(acc[i][j][q4 * 4 + 2] * r2, acc[i][j][q4 * 4 + 3] * r3));
          }
        }
      __syncthreads();
      const int bb = m0 >> 11, s0 = m0 & 2047;
#pragma unroll
      for (int it = 0; it < 16; ++it) {
        const int c = tid + 256 * it, d = c >> 4, part = c & 15;
        const int col = n0 - 1024 + d, hh = col >> 6, dd = col & 63;
        const uint4 v = *(const uint4*)(sT + d * TS + part * 8);
        *(uint4*)(P.bufB + ((size_t)((bb * 16 + hh) * 64 + dd)) * 2048 + s0 + part * 8) = v;
      }
    } else {
#pragma unroll
      for (int i = 0; i < 2; ++i)
#pragma unroll
        for (int q4 = 0; q4 < 4; ++q4) {
          const int rowb = m0 + wm * 64 + i * 32 + 8 * q4 + 4 * h;
          float rs[4];
#pragma unroll
          for (int e = 0; e < 4; ++e) rs[e] = rs_s[rowb - m0 + e];
#pragma unroll
          for (int j = 0; j < 4; ++j) {
            const int col = n0 + wn * 128 + j * 32 + r;
            if (nt < 4) {
#pragma unroll
              for (int e = 0; e < 4; ++e) P.bufA[(size_t)(rowb + e) * 1024 + col] = f2bf(acc[i][j][q4 * 4 + e] * rs[e]);
            } else {
#pragma unroll
              for (int e = 0; e < 4; ++e) P.bufC[(size_t)(rowb + e) * 1024 + col - 2048] = f2bf(acc[i][j][q4 * 4 + e] * rs[e] * (0.125f * 1.4426950408889634f));
            }
          }
        }
    }
  }
}

DI void phase_lru(const Params& P, char* smem) {
  constexpr int XS = 136;
  ushort_t* sX = (ushort_t*)smem;
  float* sAa = (float*)(smem + 128 * XS * 2);
  float* sUu = sAa + 128 * 32;
  float* segA = sUu + 128 * 32;
  float* segU = segA + 256;
  float* carry = segU + 256;
  float* cw = carry + 64;
  float* cb = cw + 512;
  const int tid = otid(), lane = tid & 63, w = tid >> 6, r = lane & 31, h = lane >> 5;
  const int items = 16 * 8 * 4;
  for (int item = obid(); item < items; item += gridDim.x) {
    const int bhd = (item & 7) * 16 + (item >> 5), cgp = (item >> 3) & 3;
    const int b = bhd >> 3, hd = bhd & 7;
    __syncthreads();
    for (int idx = tid; idx < 512; idx += NTHR) cw[idx] = P.a_conv_w[(idx >> 7) * 1024 + hd * 128 + (idx & 127)];
    if (tid < 128) cb[tid] = P.a_conv_b[hd * 128 + tid];
    if (tid < 32) carry[tid] = 0.f;
    bf16x8 br[8], bi[8];
#pragma unroll
    for (int kk = 0; kk < 8; ++kk) {
      br[kk] = *(const bf16x8*)(P.Wt_r + (size_t)(hd * 128 + cgp * 32 + r) * 128 + kk * 16 + h * 8);
      bi[kk] = *(const bf16x8*)(P.Wt_i + (size_t)(hd * 128 + cgp * 32 + r) * 128 + kk * 16 + h * 8);
    }
    const int ch = hd * 128 + cgp * 32 + r;
    const float bR = P.a_b_r[ch], bI = P.a_b_i[ch];
    const float nl = -P.a_lambda[ch];
    const float c8 = -8.f * (fmaxf(nl, 0.f) + log1pf(__expf(-fabsf(nl))));
    __syncthreads();
    const int cch = tid & 15;
    uint4 xa0, xa1, xa2, xa3, xa4, xa5, xa6, xb0, xb1, xb2, xb3, xb4, xb5, xb6;
    const ushort_t* xbase = P.bufB + ((size_t)b * S_) * 1024 + hd * 128 + cch * 8;
#define LRU_XLOAD(tt0) { \
      const int ra_ = (tt0) + (tid >> 4) * 4 - 3, rb_ = ra_ + 64; \
      const ushort_t* pa_ = xbase + (ptrdiff_t)ra_ * 1024; const ushort_t* pb_ = xbase + (ptrdiff_t)rb_ * 1024; \
      const uint4 z4_ = make_uint4(0, 0, 0, 0); const bool fz_ = ra_ < 0; \
      xa0 = fz_ ? z4_ : *(const uint4*)(pa_); xa1 = fz_ ? z4_ : *(const uint4*)(pa_ + 1024); xa2 = fz_ ? z4_ : *(const uint4*)(pa_ + 2048); \
      xa3 = *(const uint4*)(pa_ + 3 * 1024); xa4 = *(const uint4*)(pa_ + 4 * 1024); xa5 = *(const uint4*)(pa_ + 5 * 1024); xa6 = *(const uint4*)(pa_ + 6 * 1024); \
      xb0 = *(const uint4*)(pb_); xb1 = *(const uint4*)(pb_ + 1024); xb2 = *(const uint4*)(pb_ + 2048); xb3 = *(const uint4*)(pb_ + 3 * 1024); \
      xb4 = *(const uint4*)(pb_ + 4 * 1024); xb5 = *(const uint4*)(pb_ + 5 * 1024); xb6 = *(const uint4*)(pb_ + 6 * 1024); }
    LRU_XLOAD(0);
    for (int tile = 0; tile < 16; ++tile) {
      const int t0 = tile * 128;
      const int scol = tid & 31, sseg = tid >> 5;
      const size_t gbase = ((size_t)b * S_ + t0 + sseg * 16) * 1024 + hd * 128 + cgp * 32 + scol;
      {
        float wv[4][8], bv[8];
#pragma unroll
        for (int c = 0; c < 8; ++c) { bv[c] = cb[cch * 8 + c];
#pragma unroll
          for (int k = 0; k < 4; ++k) wv[k][c] = cw[k * 128 + cch * 8 + c]; }
#define CONV_TAP(k, q) a[0] += wv[k][0] * bf_lo(q.x); a[1] += wv[k][1] * bf_hi(q.x); a[2] += wv[k][2] * bf_lo(q.y); a[3] += wv[k][3] * bf_hi(q.y); \
          a[4] += wv[k][4] * bf_lo(q.z); a[5] += wv[k][5] * bf_hi(q.z); a[6] += wv[k][6] * bf_lo(q.w); a[7] += wv[k][7] * bf_hi(q.w);
#define CONV_ROW(rowl, q0, q1, q2, q3) { float a[8]; \
          _Pragma("unroll") for (int c = 0; c < 8; ++c) a[c] = bv[c]; \
          CONV_TAP(0, q0) CONV_TAP(1, q1) CONV_TAP(2, q2) CONV_TAP(3, q3) \
          *(uint4*)(sX + (rowl) * XS + cch * 8) = make_uint4(pk2(a[0], a[1]), pk2(a[2], a[3]), pk2(a[4], a[5]), pk2(a[6], a[7])); }
        const int r0 = (tid >> 4) * 4;
        CONV_ROW(r0 + 0, xa0, xa1, xa2, xa3) CONV_ROW(r0 + 1, xa1, xa2, xa3, xa4) CONV_ROW(r0 + 2, xa2, xa3, xa4, xa5) CONV_ROW(r0 + 3, xa3, xa4, xa5, xa6)
        CONV_ROW(r0 + 64, xb0, xb1, xb2, xb3) CONV_ROW(r0 + 65, xb1, xb2, xb3, xb4) CONV_ROW(r0 + 66, xb2, xb3, xb4, xb5) CONV_ROW(r0 + 67, xb3, xb4, xb5, xb6)
#undef CONV_ROW
#undef CONV_TAP
      }
      __syncthreads();
      LRU_XLOAD((tile < 15 ? tile + 1 : 15) * 128);
      ushort_t yv[16];
#pragma unroll
      for (int i = 0; i < 16; ++i) yv[i] = P.bufA[gbase + (size_t)i * 1024];
      __builtin_amdgcn_sched_barrier(0);
      f32x16 accr = zero16(), acci = zero16();
#pragma unroll
      for (int kk = 0; kk < 8; ++kk) {
        const bf16x8 a = *(const bf16x8*)(sX + (w * 32 + r) * XS + kk * 16 + h * 8);
        accr = mfma32(a, br[kk], accr);
        acci = mfma32(a, bi[kk], acci);
      }
#pragma unroll
      for (int reg = 0; reg < 16; ++reg) {
        const int row = w * 32 + crow(reg, h);
        const float xcv = bf2f(sX[row * XS + cgp * 32 + r]);
        const float rr = sigmoidf_(accr[reg] + bR), ii = sigmoidf_(acci[reg] + bI);
        const float la = c8 * rr;
        const float a = __expf(la);
        const float u = sqrtf(fmaxf(1.f - __expf(2.f * la), 0.f)) * ii * xcv;
        sAa[row * 32 + r] = a; sUu[row * 32 + r] = u;
      }
      __syncthreads();
      {
        const int col = scol, seg = sseg;
        float Aa = 1.f, Uu = 0.f;
#pragma unroll
        for (int i = 0; i < 16; ++i) { const float a = sAa[(seg * 16 + i) * 32 + col], u = sUu[(seg * 16 + i) * 32 + col]; Uu = a * Uu + u; Aa *= a; }
        segA[seg * 32 + col] = Aa; segU[seg * 32 + col] = Uu;
        __syncthreads();
        float hin = carry[(tile & 1) * 32 + col];
        for (int s2 = 0; s2 < seg; ++s2) hin = segA[s2 * 32 + col] * hin + segU[s2 * 32 + col];
#pragma unroll
        for (int i = 0; i < 16; ++i) {
          const float a = sAa[(seg * 16 + i) * 32 + col], u = sUu[(seg * 16 + i) * 32 + col];
          hin = a * hin + u;
          P.bufC[gbase + (size_t)i * 1024] = f2bf(bf2f(yv[i]) * hin);
        }
        if (seg == 7) carry[((tile + 1) & 1) * 32 + col] = hin;
      }
    }
#undef LRU_XLOAD
  }
}

template <bool MASK>
DI void sb_subtile(const f32x16& sreg, float& prun, f32x16& aout, int key0, int qidx, int h) {
  float bt[16], om[16];
#pragma unroll
  for (int i = 0; i < 16; ++i) {
    const float z = fmaxf(sreg[i], -115.f);
    const float e = __builtin_amdgcn_exp2f(-z);
    float bb = __builtin_amdgcn_rcpf(1.f + e);
    float oo = e * bb;
    if (MASK) { const bool ok = (key0 + crow(i, h)) < qidx; bb = ok ? bb : 0.f; oo = ok ? oo : 1.f; }
    bt[i] = bb; om[i] = oo;
  }
  float G[4], Gp[4];
#pragma unroll
  for (int g = 0; g < 4; ++g) { G[g] = (om[4 * g] * om[4 * g + 1]) * (om[4 * g + 2] * om[4 * g + 3]); Gp[g] = plx32(G[g], h != 0); }
  float E[4];
  float run = prun;
#pragma unroll
  for (int g = 3; g >= 0; --g) {
    const float ghi = h ? G[g] : Gp[g];
    const float glo = h ? Gp[g] : G[g];
    const float e_hi = run;
    run *= ghi;
    const float e_lo = run;
    run *= glo;
    E[g] = h ? e_hi : e_lo;
  }
  prun = run;
#pragma unroll
  for (int g = 0; g < 4; ++g) {
    float s = E[g];
    aout[4 * g + 3] = bt[4 * g + 3] * s; s *= om[4 * g + 3];
    aout[4 * g + 2] = bt[4 * g + 2] * s; s *= om[4 * g + 2];
    aout[4 * g + 1] = bt[4 * g + 1] * s; s *= om[4 * g + 1];
    aout[4 * g + 0] = bt[4 * g + 0] * s;
  }
}

DI void phase_attn(const Params& P, char* smem) {
  constexpr int KS = 72;
  ushort_t* sK = (ushort_t*)smem;
  ushort_t* sV = sK + 64 * KS;
  const int tid = otid(), lane = tid & 63, w = tid >> 6, r = lane & 31, h = lane >> 5;
  const int items = 16 * 256;
  for (int item = obid(); item < items; item += gridDim.x) {
    const int slot = item >> 8, wi = slot & 3;
    const int qt = 15 - 4 * (slot >> 2) - (wi == 0 ? 0 : wi == 1 ? 1 : wi == 2 ? 3 : 2);
    const int bh = item & 255, b = bh >> 4, hh = bh & 15;
    const int q0 = qt * 128, qw0 = q0 + w * 32, qidx = qw0 + r;
    ushort_t* qptr = P.bufC + ((size_t)b * S_ + qidx) * 1024 + hh * 64;
    bf16x8 qf[4];
#pragma unroll
    for (int kk = 0; kk < 4; ++kk) qf[kk] = *(const bf16x8*)(qptr + kk * 16 + h * 8);
    f32x16 o0 = zero16(), o1 = zero16();
    float prun = 1.f;
    const int lrow = tid >> 3, lcol = (tid & 7) * 8;
    const ushort_t* kbase = P.bufA + ((size_t)b * S_) * 1024 + hh * 64;
    const ushort_t* vbase = P.bufB + ((size_t)(b * 16 + hh) * 64) * 2048;
    const int ktmax = 2 * qt + 1;
    uint4 rk0, rk1, rv0, rv1;
    rk0 = *(const uint4*)(kbase + (size_t)(ktmax * 64 + lrow) * 1024 + lcol);
    rk1 = *(const uint4*)(kbase + (size_t)(ktmax * 64 + lrow + 32) * 1024 + lcol);
    rv0 = *(const uint4*)(vbase + (size_t)(lrow) * 2048 + ktmax * 64 + lcol);
    rv1 = *(const uint4*)(vbase + (size_t)(lrow + 32) * 2048 + ktmax * 64 + lcol);
    volatile int* dflag = (volatile int*)(smem + 2 * 64 * KS * 2);
    bool wdone = false;
    if (tid < 4) dflag[tid] = 0;
    for (int kt = ktmax; kt >= 0; --kt) {
      __syncthreads();
      if ((dflag[0] & dflag[1] & dflag[2] & dflag[3]) != 0) break;
      *(uint4*)(sK + (lrow) * KS + lcol) = rk0; *(uint4*)(sK + (lrow + 32) * KS + lcol) = rk1;
      *(uint4*)(sV + (lrow) * KS + lcol) = rv0; *(uint4*)(sV + (lrow + 32) * KS + lcol) = rv1;
      __syncthreads();
      if (kt > 0) {
        rk0 = *(const uint4*)(kbase + (size_t)((kt - 1) * 64 + lrow) * 1024 + lcol);
        rk1 = *(const uint4*)(kbase + (size_t)((kt - 1) * 64 + lrow + 32) * 1024 + lcol);
        rv0 = *(const uint4*)(vbase + (size_t)(lrow) * 2048 + (kt - 1) * 64 + lcol);
        rv1 = *(const uint4*)(vbase + (size_t)(lrow + 32) * 2048 + (kt - 1) * 64 + lcol);
      }
      if (kt * 64 <= qw0 + 30 && !wdone) {
        const bool need_mask = (kt * 64 + 63 >= qw0);
#pragma unroll
        for (int sub = 1; sub >= 0; --sub) {
          f32x16 s = zero16();
#pragma unroll
          for (int kk = 0; kk < 4; ++kk) {
            const bf16x8 kf = *(const bf16x8*)(sK + (sub * 32 + r) * KS + kk * 16 + h * 8);
            s = mfma32(kf, qf[kk], s);
          }
          f32x16 a;
          if (need_mask) sb_subtile<true>(s, prun, a, kt * 64 + sub * 32, qidx, h);
          else sb_subtile<false>(s, prun, a, kt * 64 + sub * 32, qidx, h);
#pragma unroll
          for (int st = 0; st < 2; ++st) {
            bf16x8 pf;
            {
              const unsigned p0 = pk2(a[8 * st + 0], a[8 * st + 1]), p1 = pk2(a[8 * st + 2], a[8 * st + 3]);
              const unsigned p2 = pk2(a[8 * st + 4], a[8 * st + 5]), p3 = pk2(a[8 * st + 6], a[8 * st + 7]);
              uint4 pq = make_uint4(p0, p1, p2, p3);
              pf = __builtin_bit_cast(bf16x8, pq);
            }
#pragma unroll
            for (int dt = 0; dt < 2; ++dt) {
              const ushort_t* vp = sV + (dt * 32 + r) * KS + sub * 32 + 16 * st + 4 * h;
              const uint2 v0 = *(const uint2*)vp, v1 = *(const uint2*)(vp + 8);
              uint4 vq = make_uint4(v0.x, v0.y, v1.x, v1.y);
              const bf16x8 vf = __builtin_bit_cast(bf16x8, vq);
              if (dt == 0) o0 = mfma32(vf, pf, o0); else o1 = mfma32(vf, pf, o1);
            }
          }
        }
      }
      if (!wdone && __all((int)(prun < 1e-30f))) { wdone = true; if (lane == 0) dflag[w] = 1; }
    }
    __syncthreads();
#pragma unroll
    for (int g = 0; g < 4; ++g) {
      *(uint2*)(qptr + 8 * g + 4 * h) = make_uint2(pk2(o0[4 * g], o0[4 * g + 1]), pk2(o0[4 * g + 2], o0[4 * g + 3]));
      *(uint2*)(qptr + 32 + 8 * g + 4 * h) = make_uint2(pk2(o1[4 * g], o1[4 * g + 1]), pk2(o1[4 * g + 2], o1[4 * g + 3]));
    }
  }
}

DI void ins16(float (&L)[16], float x) {
#pragma unroll
  for (int i = 0; i < 16; ++i) { const float hi = fmaxf(L[i], x); x = fminf(L[i], x); L[i] = hi; }
}

DI void merge16(float (&L)[16], const float (&O)[16]) {
#pragma unroll
  for (int i = 0; i < 16; ++i) L[i] = fmaxf(L[i], O[15 - i]);
#pragma unroll
  for (int st = 8; st >= 1; st >>= 1)
#pragma unroll
    for (int i = 0; i < 16; ++i)
      if ((i & st) == 0) { const float a = L[i], b = L[i + st]; L[i] = fmaxf(a, b); L[i + st] = fminf(a, b); }
}

DI void sort16(float (&v)[16]) {
#pragma unroll
  for (int k = 2; k <= 16; k <<= 1)
#pragma unroll
    for (int j = k >> 1; j > 0; j >>= 1)
#pragma unroll
      for (int i = 0; i < 16; ++i) {
        const int l = i ^ j;
        if (l > i) {
          const bool desc = ((i & k) == 0);
          const float a = v[i], b = v[l];
          const float mx = fmaxf(a, b), mn = fminf(a, b);
          v[i] = desc ? mx : mn; v[l] = desc ? mn : mx;
        }
      }
}

DI void phase_route(const Params& P, int layer, const ushort_t* __restrict__ hb_in, const float* __restrict__ ss_in, char* smem) {
  constexpr int QS = 136, SS = 129;
  ushort_t* sQ = (ushort_t*)(smem + GEMM_BUF);
  float* sS = (float*)smem;
  const int tid = otid(), lane = tid & 63, w = tid >> 6, wm = w >> 1, wn = w & 1, r = lane & 31, h = lane >> 5;
  const ushort_t* Wq = P.Wt_pq + (size_t)layer * 2048 * 1024;
  const ushort_t* SKl = P.SK + (size_t)layer * 8 * 2 * 128 * 128;
  const int items = (T_ / 128) * 8;
  TILE_LOOP(item, items) {
    const int mt = item >> 3, hd = item & 7, m0 = mt * 128;
    const int trow = (tid & 31) + 32 * (tid >> 6), half = (tid >> 5) & 1;
    float L0[16], L1[16];
#pragma unroll
    for (int p = 0; p < 2; ++p) {
      f32x16 acc[2][2]; for (int i = 0; i < 2; ++i) for (int j = 0; j < 2; ++j) acc[i][j] = zero16();
      gemm_mainloop(hb_in + (size_t)m0 * 1024, 1024, Wq + (size_t)(hd * 256 + p * 128) * 1024, 1024, 1024, acc, smem);
      EPI_LOOP(i, j, reg) {
        const int row = wm * 64 + i * 32 + crow(reg, h), col = wn * 64 + j * 32 + r;
        sQ[row * QS + col] = f2bf(acc[i][j][reg]);
      }
      __syncthreads();
      for (int i = 0; i < 2; ++i) for (int j = 0; j < 2; ++j) acc[i][j] = zero16();
      const ushort_t* skp = SKl + (size_t)((hd * 2 + p) * 128) * 128;
#pragma unroll
      for (int kk = 0; kk < 8; ++kk) {
        const bf16x8 a0 = *(const bf16x8*)(sQ + (wm * 64 + r) * QS + kk * 16 + h * 8);
        const bf16x8 a1 = *(const bf16x8*)(sQ + (wm * 64 + 32 + r) * QS + kk * 16 + h * 8);
        const bf16x8 b0 = *(const bf16x8*)(skp + (size_t)(wn * 64 + r) * 128 + kk * 16 + h * 8);
        const bf16x8 b1 = *(const bf16x8*)(skp + (size_t)(wn * 64 + 32 + r) * 128 + kk * 16 + h * 8);
        acc[0][0] = mfma32(a0, b0, acc[0][0]); acc[0][1] = mfma32(a0, b1, acc[0][1]);
        acc[1][0] = mfma32(a1, b0, acc[1][0]); acc[1][1] = mfma32(a1, b1, acc[1][1]);
      }
      __syncthreads();
      EPI_LOOP(i, j, reg) {
        const int row = wm * 64 + i * 32 + crow(reg, h), col = wn * 64 + j * 32 + r;
        sS[row * SS + col] = acc[i][j][reg];
      }
      __syncthreads();
      float L[16];
#pragma unroll 1
      for (int blk = 0; blk < 4; ++blk) {
        float Sv[16];
#pragma unroll
        for (int c = 0; c < 16; ++c) {
          const int n = half * 64 + blk * 16 + c;
          const float v = sS[trow * SS + n];
          Sv[c] = __uint_as_float((__float_as_uint(v) & ~0x7Fu) | (unsigned)(127 - n));
        }
        sort16(Sv);
        if (blk == 0) {
#pragma unroll
          for (int i = 0; i < 16; ++i) L[i] = Sv[i];
        } else merge16(L, Sv);
      }
      float O[16];
#pragma unroll
      for (int i = 0; i < 16; ++i) O[i] = plx32(L[i], half != 0);
      merge16(L, O);
#pragma unroll
      for (int i = 0; i < 16; ++i) { if (p == 0) L0[i] = L[i]; else L1[i] = L[i]; }
      __syncthreads();
    }
    float F[16];
#pragma unroll
    for (int j = 0; j < 16; ++j) F[j] = __uint_as_float((__float_as_uint(L0[0] + L1[j]) & ~0xFFu) | (unsigned)(255 - j));
#pragma unroll
    for (int i = 1; i < 16; ++i)
#pragma unroll
      for (int j = 0; j < 16; ++j)
        if ((i + 1) * (j + 1) <= 16) {
          const float c = L0[i] + L1[j];
          ins16(F, __uint_as_float((__float_as_uint(c) & ~0xFFu) | (unsigned)(255 - (i * 16 + j))));
        }
    float* slot = sS + tid * 33;
#pragma unroll
    for (int i = 0; i < 16; ++i) { slot[i] = L0[i]; slot[16 + i] = L1[i]; }
    const float rs = rstd_of(ss_in, m0 + trow);
    float ex[16], sum = 0.f;
#pragma unroll
    for (int k = 0; k < 16; ++k) { ex[k] = __expf((F[k] - F[0]) * rs); sum += ex[k]; }
    const float inv = 1.f / sum;
    if (half == 0) {
      unsigned ei[16];
#pragma unroll
      for (int k = 0; k < 16; ++k) {
        const unsigned ci = 255u - (__float_as_uint(F[k]) & 0xFFu);
        const unsigned i1 = 127u - (__float_as_uint(slot[ci >> 4]) & 0x7Fu);
        const unsigned i2 = 127u - (__float_as_uint(slot[16 + (ci & 15)]) & 0x7Fu);
        ei[k] = i1 * 128u + i2;
      }
      ushort_t* ep = P.eidx + (size_t)(m0 + trow) * 128 + hd * 16;
      *(uint4*)ep = make_uint4(ei[0] | (ei[1] << 16), ei[2] | (ei[3] << 16), ei[4] | (ei[5] << 16), ei[6] | (ei[7] << 16));
      *(uint4*)(ep + 8) = make_uint4(ei[8] | (ei[9] << 16), ei[10] | (ei[11] << 16), ei[12] | (ei[13] << 16), ei[14] | (ei[15] << 16));
      float* gp = P.gw + (size_t)(m0 + trow) * 128 + hd * 16;
#pragma unroll
      for (int k = 0; k < 16; k += 4) *(float4*)(gp + k) = make_float4(ex[k] * inv, ex[k + 1] * inv, ex[k + 2] * inv, ex[k + 3] * inv);
    }
    __syncthreads();
  }
}

DI void phase_expert_u(const Params& P, int layer, const ushort_t* __restrict__ hb, ushort_t* __restrict__ P8) {
  const int tid = otid(), lane = tid & 63, w = tid >> 6, b = obid();
  const int part = b & 7, wv = (b >> 3) * 4 + w, nwv = (gridDim.x >> 3) * 4;
  const int pg = lane >> 3, cl = lane & 7;
  const bool b0 = lane & 1, b1 = lane & 2, b2 = lane & 4;
  const unsigned char* Ub = P.Ub8 + (size_t)layer * 16384 * 1024 + part * 128 + cl * 16;
  ushort_t* pout = P8 + (size_t)part * T_ * 128;
  const int it0 = (b2 ? 2 : 0) + (b1 ? 4 : 0) + (b0 ? 8 : 0);
  int ne_lo, ne_hi; uint4 nxa, nxb;
#define U_LOADTOK(tt) { ne_lo = P.eidx[(size_t)(tt) * 128 + lane]; ne_hi = P.eidx[(size_t)(tt) * 128 + 64 + lane]; \
    nxa = *(const uint4*)(hb + (size_t)(tt) * 1024 + part * 128 + cl * 16); nxb = *(const uint4*)(hb + (size_t)(tt) * 1024 + part * 128 + cl * 16 + 8); }
  int t = wv;
  if (t < T_) U_LOADTOK(t);
  for (; t < T_; t += nwv) {
    const int e_lo = ne_lo, e_hi = ne_hi; const uint4 xa = nxa, xb = nxb;
    if (t + nwv < T_) U_LOADTOK(t + nwv);
    __builtin_amdgcn_sched_barrier(0);
    f32x2 x2[8];
    x2[0] = f32x2{bf_lo(xa.x), bf_hi(xa.x)}; x2[1] = f32x2{bf_lo(xa.y), bf_hi(xa.y)}; x2[2] = f32x2{bf_lo(xa.z), bf_hi(xa.z)}; x2[3] = f32x2{bf_lo(xa.w), bf_hi(xa.w)};
    x2[4] = f32x2{bf_lo(xb.x), bf_hi(xb.x)}; x2[5] = f32x2{bf_lo(xb.y), bf_hi(xb.y)}; x2[6] = f32x2{bf_lo(xb.z), bf_hi(xb.z)}; x2[7] = f32x2{bf_lo(xb.w), bf_hi(xb.w)};
    uint4 row[16];
#pragma unroll
    for (int i = 0; i < 16; ++i) {
      const int src = (8 * i + pg) & 63;
      const int e = __shfl(i < 8 ? e_lo : e_hi, src);
      row[i] = *(const uint4*)(Ub + (size_t)e * 1024);
    }
    float p[16];
#pragma unroll
    for (int i = 0; i < 16; ++i) {
      const uint4 rw = row[i];
      f32x2 a = {0.f, 0.f};
      a += __builtin_amdgcn_cvt_pk_f32_fp8((int)rw.x, false) * x2[0]; a += __builtin_amdgcn_cvt_pk_f32_fp8((int)rw.x, true) * x2[1];
      a += __builtin_amdgcn_cvt_pk_f32_fp8((int)rw.y, false) * x2[2]; a += __builtin_amdgcn_cvt_pk_f32_fp8((int)rw.y, true) * x2[3];
      a += __builtin_amdgcn_cvt_pk_f32_fp8((int)rw.z, false) * x2[4]; a += __builtin_amdgcn_cvt_pk_f32_fp8((int)rw.z, true) * x2[5];
      a += __builtin_amdgcn_cvt_pk_f32_fp8((int)rw.w, false) * x2[6]; a += __builtin_amdgcn_cvt_pk_f32_fp8((int)rw.w, true) * x2[7];
      p[i] = a.x + a.y;
    }
    float r8[8], r4[4], r2[2];
#pragma unroll
    for (int i = 0; i < 8; ++i) r8[i] = (b0 ? p[i + 8] : p[i]) + dpp_x1(b0 ? p[i] : p[i + 8]);
#pragma unroll
    for (int i = 0; i < 4; ++i) r4[i] = (b1 ? r8[i + 4] : r8[i]) + dpp_x2(b1 ? r8[i] : r8[i + 4]);
#pragma unroll
    for (int i = 0; i < 2; ++i) r2[i] = (b2 ? r4[i + 2] : r4[i]) + dpp_x4(b2 ? r4[i] : r4[i + 2]);
    ushort_t* po = pout + (size_t)t * 128 + 8 * it0 + pg;
    po[0] = f2bf(r2[0]); po[8] = f2bf(r2[1]);
  }
#undef U_LOADTOK
}

DI void phase_expert_combine(const Params& P, const ushort_t* __restrict__ P8, ushort_t* __restrict__ wb, const float* __restrict__ ss_in) {
  const size_t n4 = (size_t)T_ * 128 / 4, stride = (size_t)gridDim.x * NTHR;
  for (size_t i = (size_t)obid() * NTHR + otid(); i < n4; i += stride) {
    const int t = (int)(i >> 5);
    float4 sacc = make_float4(0.f, 0.f, 0.f, 0.f);
#pragma unroll
    for (int q = 0; q < 8; ++q) {
      const uint2 v = *(const uint2*)(P8 + (size_t)q * T_ * 128 + i * 4);
      sacc.x += bf_lo(v.x); sacc.y += bf_hi(v.x); sacc.z += bf_lo(v.y); sacc.w += bf_hi(v.y);
    }
    const float rs = rstd_of(ss_in, t) * (1.f / U_SCALE);
    const float4 g = *(const float4*)(P.gw + i * 4);
    const float w0 = g.x * gelu_tanh(sacc.x * rs) * (1.f / V_SCALE), w1 = g.y * gelu_tanh(sacc.y * rs) * (1.f / V_SCALE);
    const float w2 = g.z * gelu_tanh(sacc.z * rs) * (1.f / V_SCALE), w3 = g.w * gelu_tanh(sacc.w * rs) * (1.f / V_SCALE);
    *(uint2*)(wb + i * 4) = make_uint2(pk2(w0, w1), pk2(w2, w3));
  }
}

DI void phase_expert_v(const Params& P, int layer, ushort_t* __restrict__ hb, const ushort_t* __restrict__ wb,
                       const float* __restrict__ ss_in, float* __restrict__ ss_out) {
  const int tid = otid(), lane = tid & 63, w = tid >> 6, b = obid();
  const int part = b & 7, wv = (b >> 3) * 4 + w, nwv = (gridDim.x >> 3) * 4;
  const int pg = lane >> 3, cl = lane & 7;
  const bool b5 = lane & 32, b4 = lane & 16, b3 = lane & 8;
  const int col = part * 128 + cl * 16 + (b5 ? 8 : 0) + (b4 ? 4 : 0) + (b3 ? 2 : 0);
  const unsigned char* Vb = P.Vb8 + (size_t)layer * 16384 * 1024 + part * 128 + cl * 16;
  int ne_lo, ne_hi; float ng_lo, ng_hi; unsigned nhp;
#define V_LOADTOK(tt) { ne_lo = P.eidx[(size_t)(tt) * 128 + lane]; ne_hi = P.eidx[(size_t)(tt) * 128 + 64 + lane]; \
    ng_lo = bf2f(wb[(size_t)(tt) * 128 + lane]); ng_hi = bf2f(wb[(size_t)(tt) * 128 + 64 + lane]); \
    nhp = *(const unsigned*)(hb + (size_t)(tt) * 1024 + col); }
  int t = wv;
  if (t < T_) V_LOADTOK(t);
  for (; t < T_; t += nwv) {
    const int e_lo = ne_lo, e_hi = ne_hi; float2 hv = make_float2(bf_lo(nhp), bf_hi(nhp));
    const float w_lo = ng_lo, w_hi = ng_hi;
    if (t + nwv < T_) V_LOADTOK(t + nwv);
    __builtin_amdgcn_sched_barrier(0);
    f32x2 acc[8];
#pragma unroll
    for (int i = 0; i < 8; ++i) acc[i] = f32x2{0.f, 0.f};
    uint4 row[16]; float wg[16];
#pragma unroll
    for (int i = 0; i < 16; ++i) {
      const int src = (8 * i + pg) & 63;
      const int e = __shfl(i < 8 ? e_lo : e_hi, src);
      wg[i] = __shfl(i < 8 ? w_lo : w_hi, src);
      row[i] = *(const uint4*)(Vb + (size_t)e * 1024);
    }
#pragma unroll
    for (int i = 0; i < 16; ++i) {
      const f32x2 w2 = {wg[i], wg[i]};
      acc[0] += __builtin_amdgcn_cvt_pk_f32_fp8((int)row[i].x, false) * w2; acc[1] += __builtin_amdgcn_cvt_pk_f32_fp8((int)row[i].x, true) * w2;
      acc[2] += __builtin_amdgcn_cvt_pk_f32_fp8((int)row[i].y, false) * w2; acc[3] += __builtin_amdgcn_cvt_pk_f32_fp8((int)row[i].y, true) * w2;
      acc[4] += __builtin_amdgcn_cvt_pk_f32_fp8((int)row[i].z, false) * w2; acc[5] += __builtin_amdgcn_cvt_pk_f32_fp8((int)row[i].z, true) * w2;
      acc[6] += __builtin_amdgcn_cvt_pk_f32_fp8((int)row[i].w, false) * w2; acc[7] += __builtin_amdgcn_cvt_pk_f32_fp8((int)row[i].w, true) * w2;
    }
    f32x2 r4[4], r2[2], r1;
#pragma unroll
    for (int i = 0; i < 4; ++i) {
      r4[i] = f32x2{swap_add32(acc[i].x, acc[i + 4].x), swap_add32(acc[i].y, acc[i + 4].y)};
    }
#pragma unroll
    for (int i = 0; i < 2; ++i) {
      r2[i] = f32x2{swap_add16(r4[i].x, r4[i + 2].x), swap_add16(r4[i].y, r4[i + 2].y)};
    }
    {
      const f32x2 keep = b3 ? r2[1] : r2[0], send = b3 ? r2[0] : r2[1];
      r1 = keep + f32x2{dpp_x8(send.x), dpp_x8(send.y)};
    }
    hv.x += r1.x; hv.y += r1.y;
    *(unsigned*)(hb + (size_t)t * 1024 + col) = pk2(hv.x, hv.y);
    float sq = hv.x * hv.x + hv.y * hv.y;
    sq += dpp_x1(sq); sq += dpp_x2(sq); sq += dpp_x4(sq); sq += dpp_x8(sq); sq = swap_add16(sq, sq); sq = swap_add32(sq, sq);
    if (lane == 0) ss_out[(size_t)t * 8 + part] = sq;
  }
#undef V_LOADTOK
}

DI void phase_final(const Params& P, const ushort_t* __restrict__ hb, const float* __restrict__ ss) {
  const size_t n8 = (size_t)T_ * 1024 / 8, stride = (size_t)gridDim.x * NTHR;
  for (size_t i = (size_t)obid() * NTHR + otid(); i < n8; i += stride) {
    const int row = (int)(i >> 7), c = (int)(i & 127) * 8;
    const float rs = rstd_of(ss, row);
    const uint4 u = *(const uint4*)(hb + i * 8);
    const float4 g0 = *(const float4*)(P.final_norm + c), g1 = *(const float4*)(P.final_norm + c + 4);
    *(float4*)(P.h + i * 8) = make_float4(bf_lo(u.x) * rs * g0.x, bf_hi(u.x) * rs * g0.y, bf_lo(u.y) * rs * g0.z, bf_hi(u.y) * rs * g0.w);
    *(float4*)(P.h + i * 8 + 4) = make_float4(bf_lo(u.z) * rs * g1.x, bf_hi(u.z) * rs * g1.y, bf_lo(u.w) * rs * g1.z, bf_hi(u.w) * rs * g1.w);
  }
}

#define XB_TMO      128
#define XB_XCNT(j)  (256  + 64 * (j))
#define XB_XSUB(j)  (1280 + 64 * (j))
#define XB_XGEN(j)  (2304 + 64 * (j))
#define XB_TOP      3328
#define XB_TOPGEN   3392
#define XCD_BAR_WORDS 3456
#define XB_SPIN_CAP (1u << 22)
#define LAS __attribute__((address_space(3)))
DI unsigned xb_ld(unsigned* p) { return __hip_atomic_load(p, __ATOMIC_RELAXED, __HIP_MEMORY_SCOPE_AGENT); }
DI unsigned xb_add(unsigned* p, unsigned v) { return __hip_atomic_fetch_add(p, v, __ATOMIC_RELAXED, __HIP_MEMORY_SCOPE_AGENT); }
DI unsigned xb_xcc_id() { return (unsigned)__builtin_amdgcn_s_getreg((3 << 11) | 20) & 0xFu; }
#define XB_SPIN(cond, bar) do { unsigned _sp = 0; while (cond) { __builtin_amdgcn_s_sleep(1); \
    if ((++_sp & 255u) == 0u) { if (xb_ld(&(bar)[XB_TMO])) break; if (_sp > XB_SPIN_CAP) { atomicAdd(&(bar)[XB_TMO], 1u); break; } } } } while (0)
struct XcdBarrier { unsigned* bar; unsigned x; volatile LAS unsigned* st; };
DI XcdBarrier xcd_barrier_post(unsigned* bar, volatile LAS unsigned* st) {
  XcdBarrier b; b.bar = bar; b.x = xb_xcc_id(); b.st = st;
  if (threadIdx.x == 0) (void)xb_add(&bar[XB_XCNT(b.x)], 1u);
  return b;
}
DI void xcd_barrier_complete(unsigned* bar, unsigned x, unsigned& nloc, unsigned& nx) {
  const unsigned G = gridDim.x * gridDim.y * gridDim.z;
  unsigned sum, cnt, mine, sp = 0u;
  for (;;) {
    sum = 0u; cnt = 0u; mine = 0u;
#pragma unroll
    for (unsigned j = 0; j < 16; ++j) { const unsigned c = xb_ld(&bar[XB_XCNT(j)]); sum += c; cnt += (c > 0u) ? 1u : 0u; mine = (j == x) ? c : mine; }
    if (sum == G) break;
    __builtin_amdgcn_s_sleep(1);
    if ((++sp & 255u) == 0u) { if (xb_ld(&bar[XB_TMO])) break; if (sp > XB_SPIN_CAP) { atomicAdd(&bar[XB_TMO], 1u); break; } }
  }
  nloc = mine > 0u ? mine : 1u; nx = cnt > 0u ? cnt : 1u;
}
DI void xcd_barrier(const XcdBarrier& b) {
  asm volatile("s_waitcnt vmcnt(0)" ::: "memory");
  __syncthreads();
  if (threadIdx.x == 0) {
    unsigned* bar = b.bar;
    __builtin_amdgcn_s_waitcnt(0);
    unsigned nloc = b.st[0], nx = b.st[1];
    if (nloc == 0u) { xcd_barrier_complete(bar, b.x, nloc, nx); b.st[0] = nloc; b.st[1] = nx; }
    const unsigned old = xb_add(&bar[XB_XSUB(b.x)], 1u);
    const unsigned gen = old / nloc;
    if (old + 1u == (gen + 1u) * nloc) {
      __builtin_amdgcn_fence(__ATOMIC_RELEASE, "agent");
      asm volatile("s_waitcnt vmcnt(0)" ::: "memory");
      const unsigned og = xb_add(&bar[XB_TOP], 1u);
      const unsigned tg = og / nx;
      if (og + 1u == (tg + 1u) * nx) xb_add(&bar[XB_TOPGEN], 1u);
      else XB_SPIN(xb_ld(&bar[XB_TOPGEN]) == tg, bar);
      __builtin_amdgcn_fence(__ATOMIC_ACQUIRE, "agent");
      xb_add(&bar[XB_XGEN(b.x)], 1u);
      asm volatile("s_waitcnt vmcnt(0)" ::: "memory");
    } else {
      XB_SPIN(xb_ld(&bar[XB_XGEN(b.x)]) == gen, bar);
      __builtin_amdgcn_fence(__ATOMIC_ACQUIRE, "agent");
      asm volatile("s_waitcnt vmcnt(0)" ::: "memory");
    }
  }
  __syncthreads();
}

DI void run_phase(const Params& P, int ph, char* smem) {
  ushort_t* P8 = P.bufA;
  ushort_t* wb = P.bufB;
  switch (ph) {
    case 0: phase_prep(P, smem); break;
    case 1: phase_in(P, smem); break;
    case 2: phase_lru(P, smem); break;
    case 3: phase_resid_gemm<false>(P.bufC, P.Wt_out, nullptr, P.hb0, P.hb0, P.ssA, smem); break;
    case 4: phase_route(P, 0, P.hb0, P.ssA, smem); break;
    case 5: phase_expert_u(P, 0, P.hb0, P8); break;
    case 6: phase_expert_combine(P, P8, wb, P.ssA); break;
    case 7: phase_expert_v(P, 0, P.hb0, wb, P.ssA, P.ssB); break;
    case 8: phase_ple(P, 0, P.hb0, P.hb1, P.ssB, P.ssA, smem); break;
    case 9: phase_kvq(P, P.hb1, P.ssA, smem); break;
    case 10: phase_attn(P, smem); break;
    case 11: phase_resid_gemm<false>(P.bufC, P.Wt_o, nullptr, P.hb1, P.hb1, P.ssB, smem); break;
    case 12: phase_route(P, 1, P.hb1, P.ssB, smem); break;
    case 13: phase_expert_u(P, 1, P.hb1, P8); break;
    case 14: phase_expert_combine(P, P8, wb, P.ssB); break;
    case 15: phase_expert_v(P, 1, P.hb1, wb, P.ssB, P.ssA); break;
    case 16: phase_ple(P, 1, P.hb1, P.hb0, P.ssA, P.ssB, smem); break;
    case 17: phase_final(P, P.hb0, P.ssB); break;
    default: break;
  }
}

#if MEGA
__global__ void __launch_bounds__(NTHR, 2) mega_kernel(Params P) {
  __shared__ __attribute__((aligned(16))) char smem[SMEM_BYTES];
  __shared__ uint4 xb_words;
  if (threadIdx.x == 0) xb_words = make_uint4(0u, 0u, 0u, 0u);
  __syncthreads();
  XcdBarrier xb = xcd_barrier_post(P.bar, (volatile LAS unsigned*)&xb_words);
  if (P.bar == nullptr) cg::this_grid().sync();
#define PH_(n) run_phase(P, n, smem); xcd_barrier(xb);
  PH_(0) PH_(1) PH_(2) PH_(3) PH_(4) PH_(5) PH_(6) PH_(7) PH_(8) PH_(9) PH_(10) PH_(11) PH_(12) PH_(13) PH_(14) PH_(15) PH_(16)
#undef PH_
  run_phase(P, 17, smem);
}
#else
template <int PH>
__global__ void __launch_bounds__(NTHR, 2) phase_kernel(Params P) {
  __shared__ __attribute__((aligned(16))) char smem[SMEM_BYTES];
  run_phase(P, PH, smem);
}
template <int PH> static void launch_phases(const Params& P, hipStream_t stream) {
  phase_kernel<PH><<<512, NTHR, 0, stream>>>(P);
  if constexpr (PH + 1 < 18) launch_phases<PH + 1>(P, stream);
}
#endif

extern "C" void kernel_launch(void* const* d_in, const int* in_sizes, int n_in, void* d_out, int out_size, void* d_ws,
                              size_t ws_size, hipStream_t stream) {
  Params P{};
  const float** fp = (const float**)&P;
  for (int i = 0; i < 25; ++i) fp[i] = (const float*)d_in[i];
  P.h = (float*)d_out;
  char* ws = (char*)d_ws;
  const size_t MB = 1024 * 1024;
  size_t off = 0;
  auto take = [&](size_t bytes) { char* p = ws + off; off += (bytes + 255) & ~(size_t)255; return p; };
  P.Wt_in = (ushort_t*)take(4 * MB); P.Wt_out = (ushort_t*)take(2 * MB); P.Wt_kvq = (ushort_t*)take(6 * MB);
  P.Wt_o = (ushort_t*)take(2 * MB); P.Wt_pq = (ushort_t*)take(8 * MB); P.Wt_gate = (ushort_t*)take(4 * MB);
  P.Wt_proj = (ushort_t*)take(1 * MB); P.Wt_r = (ushort_t*)take(256 * 1024); P.Wt_i = (ushort_t*)take(256 * 1024);
  P.SK = (ushort_t*)take(1 * MB);
  P.Ub8 = (unsigned char*)take(32 * MB); P.Vb8 = (unsigned char*)take(32 * MB); P.pb = (ushort_t*)take(32 * MB);
  P.hb0 = (ushort_t*)take(64 * MB); P.hb1 = (ushort_t*)take(64 * MB);
  P.bufA = (ushort_t*)take(64 * MB); P.bufB = (ushort_t*)take(64 * MB); P.bufC = (ushort_t*)take(64 * MB);
  P.eidx = (ushort_t*)take(8 * MB); P.gw = (float*)take(16 * MB);
  P.ssA = (float*)take(1 * MB); P.ssB = (float*)take(1 * MB);
  P.bar = (unsigned*)take(64 * 1024);
  if (off > ws_size) { fprintf(stderr, "workspace too small: need %zu have %zu\n", off, ws_size); return; }
#if MEGA
  static int grid_blocks = 0;
  if (!grid_blocks) {
    int dev = 0, cus = 0, per_cu = 0;
    hipGetDevice(&dev);
    hipDeviceGetAttribute(&cus, hipDeviceAttributeMultiprocessorCount, dev);
    hipOccupancyMaxActiveBlocksPerMultiprocessor(&per_cu, mega_kernel, NTHR, 0);
    if (per_cu > 2) per_cu = 2;
    if (per_cu < 1) per_cu = 1;
    grid_blocks = cus * per_cu;
  }
  void* args[] = {&P};
  hipMemsetAsync(P.bar, 0, XCD_BAR_WORDS * sizeof(unsigned), stream);
  hipError_t e = hipLaunchCooperativeKernel((void*)mega_kernel, dim3(grid_blocks), dim3(NTHR), args, 0, stream);
  if (e != hipSuccess) fprintf(stderr, "cooperative launch failed: %s (grid %d)\n", hipGetErrorString(e), grid_blocks);
#else
  launch_phases<0>(P, stream);
#endif
}
```

```cpp
#include <hip/hip_runtime.h>
#include <hip/hip_cooperative_groups.h>
#include <cstdio>
#include <cstdint>
namespace cg = cooperative_groups;

#ifndef MEGA
#define MEGA 1
#endif

#define DI __device__ __forceinline__
typedef unsigned short ushort_t;
typedef short bf16x8 __attribute__((ext_vector_type(8)));
typedef float f32x16 __attribute__((ext_vector_type(16)));
typedef float f32x2_t __attribute__((ext_vector_type(2)));
typedef __bf16 bf16x2_t __attribute__((ext_vector_type(2)));
typedef float f32x2 __attribute__((ext_vector_type(2)));

constexpr int T_ = 32768, D_ = 1024, S_ = 2048;
constexpr int NTHR = 256;
constexpr int SMEM_BYTES = 73728 + 2048;
constexpr int XTRA_OFF = 73728;

struct Params {
  const float *x, *p, *norm_mix, *a_w_in, *a_conv_w, *a_conv_b, *a_w_r, *a_w_i, *a_b_r, *a_b_i, *a_lambda, *a_w_out,
      *kv_norm, *w_kv, *b_w_q, *b_w_o, *norm_ffn, *peer_w_q, *peer_sub_keys, *peer_u, *peer_v, *norm_ple, *ple_w_gate,
      *ple_w_proj, *final_norm;
  float* h;
  ushort_t *Wt_in, *Wt_out, *Wt_kvq, *Wt_o, *Wt_pq, *Wt_gate, *Wt_proj, *Wt_r, *Wt_i, *SK;
  unsigned char *Ub8, *Vb8; ushort_t *pb, *hb0, *hb1, *bufA, *bufB, *bufC, *eidx;
  float *gw, *ssA, *ssB;
  unsigned* bar;
};

DI unsigned pk2(float lo, float hi) { f32x2_t v = {lo, hi}; bf16x2_t b = __builtin_convertvector(v, bf16x2_t); return __builtin_bit_cast(unsigned, b); }
DI ushort_t f2bf(float x) { return (ushort_t)(pk2(x, 0.f) & 0xffffu); }
DI float bf_lo(unsigned u) { return __uint_as_float(u << 16); }
DI float bf_hi(unsigned u) { return __uint_as_float(u & 0xffff0000u); }
DI float bf2f(ushort_t u) { return __uint_as_float(((unsigned)u) << 16); }
DI float sigmoidf_(float x) { return __builtin_amdgcn_rcpf(1.f + __expf(-x)); }
DI float gelu_tanh(float x) { float u = 1.5957691216057308f * (x + 0.044715f * x * x * x); return x * __builtin_amdgcn_rcpf(1.f + __expf(-u)); }
DI f32x16 mfma32(bf16x8 a, bf16x8 b, f32x16 c) { return __builtin_amdgcn_mfma_f32_32x32x16_bf16(a, b, c, 0, 0, 0); }
DI f32x16 zero16() { f32x16 z; for (int i = 0; i < 16; ++i) z[i] = 0.f; return z; }
DI int otid() { int t = threadIdx.x; asm volatile("" : "+v"(t)); return t; }
DI int obid() { int b = blockIdx.x; asm volatile("" : "+s"(b)); return b; }
DI float dpp_x1(float x) { return __int_as_float(__builtin_amdgcn_update_dpp(0, __float_as_int(x), 0xB1, 0xF, 0xF, false)); }
DI float dpp_x2(float x) { return __int_as_float(__builtin_amdgcn_update_dpp(0, __float_as_int(x), 0x4E, 0xF, 0xF, false)); }
DI float dpp_x4(float x) {
  int t = __builtin_amdgcn_update_dpp(0, __float_as_int(x), 0x104, 0xF, 0x5, false);
  t = __builtin_amdgcn_update_dpp(t, __float_as_int(x), 0x114, 0xF, 0xA, false);
  return __int_as_float(t);
}
DI float dpp_x8(float x) { return __int_as_float(__builtin_amdgcn_update_dpp(0, __float_as_int(x), 0x128, 0xF, 0xF, false)); }
DI float swap_add32(float a, float b) { const auto r = __builtin_amdgcn_permlane32_swap(__float_as_uint(a), __float_as_uint(b), false, false); return __uint_as_float(r[0]) + __uint_as_float(r[1]); }
DI float swap_add16(float a, float b) { const auto r = __builtin_amdgcn_permlane16_swap(__float_as_uint(a), __float_as_uint(b), false, false); return __uint_as_float(r[0]) + __uint_as_float(r[1]); }
DI float plx32(float x, bool upper) { const auto r = __builtin_amdgcn_permlane32_swap(__float_as_uint(x), __float_as_uint(x), false, false); return __uint_as_float(upper ? r[0] : r[1]); }
DI float plx16(float x, bool odd) { const auto r = __builtin_amdgcn_permlane16_swap(__float_as_uint(x), __float_as_uint(x), false, false); return __uint_as_float(odd ? r[0] : r[1]); }
DI int crow(int reg, int h) { return (reg & 3) + 8 * (reg >> 2) + 4 * h; }

DI void tconv(const float* __restrict__ W, const float* __restrict__ g, ushort_t* __restrict__ Wt, int K, int N, int nb,
              int& base, char* smem) {
  float* tile = (float*)smem;
  const int tid = otid(), G = gridDim.x;
  const int tk = K / 64, tn = N / 64, count = nb * tk * tn;
  int start = (obid() - (base % G) + G) % G;
  for (int t = start; t < count; t += G) {
    const int b = t / (tk * tn), rem = t % (tk * tn), kt = rem / tn, nt = rem % tn;
    const float* src = W + (size_t)b * K * N + (size_t)(kt * 64) * N + nt * 64;
    __syncthreads();
    {
      const int ty = tid >> 4, tx = tid & 15;
#pragma unroll
      for (int i = 0; i < 4; ++i) {
        const int kr = ty + 16 * i;
        float4 v = *(const float4*)(src + (size_t)kr * N + tx * 4);
        const float gs = g ? g[kt * 64 + kr] : 1.f;
        tile[kr * 65 + tx * 4 + 0] = v.x * gs; tile[kr * 65 + tx * 4 + 1] = v.y * gs;
        tile[kr * 65 + tx * 4 + 2] = v.z * gs; tile[kr * 65 + tx * 4 + 3] = v.w * gs;
      }
    }
    __syncthreads();
    {
      const int n = tid >> 2, kc = tid & 3;
      unsigned o[8];
#pragma unroll
      for (int i = 0; i < 8; ++i) o[i] = pk2(tile[(kc * 16 + 2 * i) * 65 + n], tile[(kc * 16 + 2 * i + 1) * 65 + n]);
      ushort_t* dst = Wt + (size_t)b * K * N + (size_t)(nt * 64 + n) * K + kt * 64 + kc * 16;
      *(uint4*)dst = make_uint4(o[0], o[1], o[2], o[3]);
      *(uint4*)(dst + 8) = make_uint4(o[4], o[5], o[6], o[7]);
    }
  }
  base += count;
}

DI void econv(const float* __restrict__ src, const float* __restrict__ g, ushort_t* __restrict__ dst, size_t n8) {
  const size_t stride = (size_t)gridDim.x * NTHR;
  for (size_t i = (size_t)obid() * NTHR + otid(); i < n8; i += stride) {
    float4 a = *(const float4*)(src + i * 8), b = *(const float4*)(src + i * 8 + 4);
    if (g) {
      const int c = (int)((i * 8) & 1023);
      float4 ga = *(const float4*)(g + c), gb = *(const float4*)(g + c + 4);
      a.x *= ga.x; a.y *= ga.y; a.z *= ga.z; a.w *= ga.w; b.x *= gb.x; b.y *= gb.y; b.z *= gb.z; b.w *= gb.w;
    }
    *(uint4*)(dst + i * 8) = make_uint4(pk2(a.x, a.y), pk2(a.z, a.w), pk2(b.x, b.y), pk2(b.z, b.w));
  }
}

constexpr float U_SCALE = 128.f, V_SCALE = 32.f;
DI void econv8(const float* __restrict__ src, const float* __restrict__ g, unsigned char* __restrict__ dst, size_t n16, float scale) {
  const size_t stride = (size_t)gridDim.x * NTHR;
  for (size_t i = (size_t)obid() * NTHR + otid(); i < n16; i += stride) {
    unsigned o[4];
#pragma unroll
    for (int q = 0; q < 4; ++q) {
      float4 a = *(const float4*)(src + i * 16 + q * 4);
      if (g) { const float4 ga = *(const float4*)(g + ((i * 16 + q * 4) & 1023)); a.x *= ga.x; a.y *= ga.y; a.z *= ga.z; a.w *= ga.w; }
      int v = 0;
      v = __builtin_amdgcn_cvt_pk_fp8_f32(a.x * scale, a.y * scale, v, false);
      v = __builtin_amdgcn_cvt_pk_fp8_f32(a.z * scale, a.w * scale, v, true);
      o[q] = (unsigned)v;
    }
    *(uint4*)(dst + i * 16) = make_uint4(o[0], o[1], o[2], o[3]);
  }
}

DI void conv_tables(const Params& P, int layer) {
  econv8(P.peer_u + (size_t)layer * 16384 * 1024, P.norm_ffn + layer * 1024, P.Ub8 + (size_t)layer * 16384 * 1024, (size_t)16384 * 1024 / 16, U_SCALE);
  econv8(P.peer_v + (size_t)layer * 16384 * 1024, nullptr, P.Vb8 + (size_t)layer * 16384 * 1024, (size_t)16384 * 1024 / 16, V_SCALE);
}

DI void phase_prep(const Params& P, char* smem) {
  int base = 0;
  tconv(P.a_w_in, P.norm_mix, P.Wt_in, 1024, 2048, 1, base, smem);
  tconv(P.a_w_r, nullptr, P.Wt_r, 128, 128, 8, base, smem);
  tconv(P.a_w_i, nullptr, P.Wt_i, 128, 128, 8, base, smem);
  tconv(P.a_w_out, nullptr, P.Wt_out, 1024, 1024, 1, base, smem);
  tconv(P.w_kv, P.kv_norm, P.Wt_kvq, 1024, 2048, 1, base, smem);
  tconv(P.b_w_q, P.norm_mix + 1024, P.Wt_kvq + (size_t)2048 * 1024, 1024, 1024, 1, base, smem);
  tconv(P.b_w_o, nullptr, P.Wt_o, 1024, 1024, 1, base, smem);
  for (int l = 0; l < 2; ++l) {
    tconv(P.peer_w_q + (size_t)l * 1024 * 2048, P.norm_ffn + l * 1024, P.Wt_pq + (size_t)l * 2048 * 1024, 1024, 2048, 1, base, smem);
    tconv(P.ple_w_gate + (size_t)l * 1024 * 1024, P.norm_ple + l * 1024, P.Wt_gate + (size_t)l * 1024 * 1024, 1024, 1024, 1, base, smem);
    tconv(P.ple_w_proj + (size_t)l * 256 * 1024, nullptr, P.Wt_proj + (size_t)l * 256 * 1024, 256, 1024, 1, base, smem);
  }
  econv(P.peer_sub_keys, nullptr, P.SK, (size_t)2 * 8 * 2 * 128 * 128 / 8);
  conv_tables(P, 0);
  conv_tables(P, 1);
  econv(P.p, nullptr, P.pb, (size_t)2 * T_ * 256 / 8);
  {
    const size_t n8 = (size_t)T_ * 1024 / 8, stride = (size_t)gridDim.x * NTHR;
    for (size_t i = (size_t)obid() * NTHR + otid(); i < n8; i += stride) {
      float4 a = *(const float4*)(P.x + i * 8), b = *(const float4*)(P.x + i * 8 + 4);
      *(uint4*)(P.hb0 + i * 8) = make_uint4(pk2(a.x, a.y), pk2(a.z, a.w), pk2(b.x, b.y), pk2(b.z, b.w));
      float s = a.x * a.x + a.y * a.y + a.z * a.z + a.w * a.w + b.x * b.x + b.y * b.y + b.z * b.z + b.w * b.w;
      s += dpp_x1(s); s += dpp_x2(s); s += dpp_x4(s); s += dpp_x8(s);
      if ((otid() & 15) == 0) P.ssA[i >> 4] = s;
    }
  }
}

constexpr int GEMM_BUF = 2 * 128 * 128;
constexpr int GEMM_SMEM = 2 * GEMM_BUF;
DI void glds16(const void* gsrc, unsigned lds_dst) {
  unsigned keep;
  asm volatile("s_mov_b32 %0, m0\n\ts_mov_b32 m0, %2\n\ts_nop 0\n\tglobal_load_lds_dwordx4 %1, off\n\ts_mov_b32 m0, %0"
               : "=&s"(keep) : "v"(gsrc), "s"(lds_dst) : "memory");
}
DI void gemm_mainloop(const ushort_t* __restrict__ A, int lda, const ushort_t* __restrict__ Bt, int ldb, int K,
                      f32x16 (&acc)[2][2], char* smem) {
  const int tid = otid(), lane = tid & 63, w = tid >> 6, wm = w >> 1, wn = w & 1, r = lane & 31, h = lane >> 5;
  const unsigned lds0 = (unsigned)(size_t)smem;
  const int drow = w * 32 + (lane >> 3);
  const ushort_t* ga[4]; const ushort_t* gb[4];
#pragma unroll
  for (int q = 0; q < 4; ++q) {
    const int row = drow + q * 8;
    const int kc = (lane & 7) ^ ((row >> 1) & 7);
    ga[q] = A + (size_t)row * lda + kc * 8;
    gb[q] = Bt + (size_t)row * ldb + kc * 8;
  }
  const unsigned dstw = (unsigned)__builtin_amdgcn_readfirstlane((int)(lds0 + (unsigned)(w * 32) * 128u));
#define G_DMA(buf, koff) { _Pragma("unroll") for (int q = 0; q < 4; ++q) { \
      glds16(ga[q] + (koff), dstw + (unsigned)((buf) * GEMM_BUF + q * 1024)); \
      glds16(gb[q] + (koff), dstw + (unsigned)((buf) * GEMM_BUF + 16384 + q * 1024)); } }
  unsigned offA[2][4], offB[2][4];
#pragma unroll
  for (int i = 0; i < 2; ++i)
#pragma unroll
    for (int kk = 0; kk < 4; ++kk) {
      const int ra_ = wm * 64 + i * 32 + r, rb_ = wn * 64 + i * 32 + r, kc = kk * 2 + h;
      offA[i][kk] = (unsigned)(ra_ * 128 + ((kc ^ ((ra_ >> 1) & 7)) * 16));
      offB[i][kk] = (unsigned)(16384 + rb_ * 128 + ((kc ^ ((rb_ >> 1) & 7)) * 16));
    }
  const int nk = K >> 6;
  __syncthreads();
  G_DMA(0, 0);
  asm volatile("s_waitcnt vmcnt(0)" ::: "memory");
  __syncthreads();
  for (int it = 0; it < nk; ++it) {
    const int buf = it & 1;
    if (it + 1 < nk) G_DMA(buf ^ 1, (it + 1) * 64);
    const char* st = smem + buf * GEMM_BUF;
#pragma unroll
    for (int kk = 0; kk < 4; ++kk) {
      const bf16x8 a0 = *(const bf16x8*)(st + offA[0][kk]);
      const bf16x8 a1 = *(const bf16x8*)(st + offA[1][kk]);
      const bf16x8 b0 = *(const bf16x8*)(st + offB[0][kk]);
      const bf16x8 b1 = *(const bf16x8*)(st + offB[1][kk]);
      acc[0][0] = mfma32(a0, b0, acc[0][0]); acc[0][1] = mfma32(a0, b1, acc[0][1]);
      acc[1][0] = mfma32(a1, b0, acc[1][0]); acc[1][1] = mfma32(a1, b1, acc[1][1]);
    }
    asm volatile("s_waitcnt vmcnt(0)" ::: "memory");
    __syncthreads();
  }
#undef G_DMA
}

constexpr int WST = 24576;
DI void gemm_mainloop_w(const ushort_t* __restrict__ A, int lda, const ushort_t* __restrict__ Bt, int ldb, int K,
                        f32x16 (&acc)[2][4], char* smem) {
  const int tid = otid(), lane = tid & 63, w = tid >> 6, wm = w >> 1, wn = w & 1, r = lane & 31, h = lane >> 5;
  const unsigned lds0 = (unsigned)(size_t)smem;
  const ushort_t* ga[2]; const ushort_t* gb[4];
#pragma unroll
  for (int q = 0; q < 2; ++q) {
    const int row = (2 * w + q) * 16 + (lane >> 2);
    ga[q] = A + (size_t)row * lda + (((lane & 3) ^ ((row >> 2) & 3)) * 8);
  }
#pragma unroll
  for (int q = 0; q < 4; ++q) {
    const int row = (4 * w + q) * 16 + (lane >> 2);
    gb[q] = Bt + (size_t)row * ldb + (((lane & 3) ^ ((row >> 2) & 3)) * 8);
  }
  const unsigned dsta = (unsigned)__builtin_amdgcn_readfirstlane((int)(lds0 + (unsigned)(2 * w) * 1024u));
  const unsigned dstb = (unsigned)__builtin_amdgcn_readfirstlane((int)(lds0 + 8192u + (unsigned)(4 * w) * 1024u));
#define GW_DMA(stg, koff) { _Pragma("unroll") for (int q = 0; q < 2; ++q) glds16(ga[q] + (koff), dsta + (unsigned)((stg) * WST + q * 1024)); \
    _Pragma("unroll") for (int q = 0; q < 4; ++q) glds16(gb[q] + (koff), dstb + (unsigned)((stg) * WST + q * 1024)); }
  unsigned offA[2][2], offB[4][2];
#pragma unroll
  for (int kk = 0; kk < 2; ++kk) {
    const int kc = kk * 2 + h;
#pragma unroll
    for (int i = 0; i < 2; ++i) { const int ra_ = wm * 64 + i * 32 + r; offA[i][kk] = (unsigned)(ra_ * 64 + ((kc ^ ((ra_ >> 2) & 3)) * 16)); }
#pragma unroll
    for (int j = 0; j < 4; ++j) { const int rb_ = wn * 128 + j * 32 + r; offB[j][kk] = (unsigned)(8192 + rb_ * 64 + ((kc ^ ((rb_ >> 2) & 3)) * 16)); }
  }
  const int nk = K >> 5;
  __syncthreads();
  GW_DMA(0, 0);
  asm volatile("s_waitcnt vmcnt(0)" ::: "memory");
  __syncthreads();
  for (int it = 0; it < nk; ++it) {
    const int buf = it & 1;
    if (it + 1 < nk) GW_DMA(buf ^ 1, (it + 1) * 32);
    const char* st = smem + buf * WST;
#pragma unroll
    for (int kk = 0; kk < 2; ++kk) {
      const bf16x8 a0 = *(const bf16x8*)(st + offA[0][kk]);
      const bf16x8 a1 = *(const bf16x8*)(st + offA[1][kk]);
#pragma unroll
      for (int j = 0; j < 4; ++j) {
        const bf16x8 bj = *(const bf16x8*)(st + offB[j][kk]);
        acc[0][j] = mfma32(a0, bj, acc[0][j]);
        acc[1][j] = mfma32(a1, bj, acc[1][j]);
      }
    }
    asm volatile("s_waitcnt vmcnt(0)" ::: "memory");
    __syncthreads();
  }
#undef GW_DMA
}

DI void tile_rowsumsq_w(const f32x16 (&v)[2][4], float* red, float* __restrict__ ss_out, int m0, int nt) {
  const int tid = otid(), lane = tid & 63, w = tid >> 6, wm = w >> 1, wn = w & 1, r = lane & 31, h = lane >> 5;
  __syncthreads();
#pragma unroll
  for (int i = 0; i < 2; ++i)
#pragma unroll
    for (int reg = 0; reg < 16; ++reg) {
      float s = v[i][0][reg] * v[i][0][reg] + v[i][1][reg] * v[i][1][reg] + v[i][2][reg] * v[i][2][reg] + v[i][3][reg] * v[i][3][reg];
      s += dpp_x1(s); s += dpp_x2(s); s += dpp_x4(s); s += dpp_x8(s); s = swap_add16(s, s);
      if (r == 0) red[wn * 128 + wm * 64 + i * 32 + crow(reg, h)] = s;
    }
  __syncthreads();
  if (tid < 128) *(float2*)(ss_out + (size_t)(m0 + tid) * 8 + 2 * nt) = make_float2(red[tid] + red[128 + tid], 0.f);
}

#define TILE_LOOP(t, tiles) for (int slot_ = (obid() >> 3), per_ = (tiles) >> 3, t = (obid() & 7) * per_ + slot_; slot_ < per_; slot_ += (int)(gridDim.x >> 3), t += (int)(gridDim.x >> 3))

DI float rstd_of(const float* __restrict__ ss, int row) {
  const float4 a = *(const float4*)(ss + (size_t)row * 8), b = *(const float4*)(ss + (size_t)row * 8 + 4);
  return rsqrtf((a.x + a.y + a.z + a.w + b.x + b.y + b.z + b.w) * (1.f / 1024.f) + 1e-6f);
}

DI void tile_rowsumsq(const f32x16 (&v)[2][2], float* red, float* __restrict__ ss_out, int m0, int nt) {
  const int tid = otid(), lane = tid & 63, w = tid >> 6, wm = w >> 1, wn = w & 1, r = lane & 31, h = lane >> 5;
  __syncthreads();
#pragma unroll
  for (int i = 0; i < 2; ++i)
#pragma unroll
    for (int reg = 0; reg < 16; ++reg) {
      float s = v[i][0][reg] * v[i][0][reg] + v[i][1][reg] * v[i][1][reg];
      s += dpp_x1(s); s += dpp_x2(s); s += dpp_x4(s); s += dpp_x8(s); s = swap_add16(s, s);
      if (r == 0) red[wn * 128 + wm * 64 + i * 32 + crow(reg, h)] = s;
    }
  __syncthreads();
  if (tid < 128) ss_out[(size_t)(m0 + tid) * 8 + nt] = red[tid] + red[128 + tid];
}

#define EPI_LOOP(i, j, reg) _Pragma("unroll") for (int i = 0; i < 2; ++i) _Pragma("unroll") for (int j = 0; j < 2; ++j) _Pragma("unroll") for (int reg = 0; reg < 16; ++reg)

DI void phase_in(const Params& P, char* smem) {
  const int tid = otid(), lane = tid & 63, w = tid >> 6, wm = w >> 1, wn = w & 1, r = lane & 31, h = lane >> 5;
  const int NT = 8, tiles = (T_ / 128) * NT;
  TILE_LOOP(t, tiles) {
    const int mt = t / NT, nt = t % NT, m0 = mt * 128, n0 = nt * 256;
    f32x16 acc[2][4];
#pragma unroll
    for (int i = 0; i < 2; ++i)
#pragma unroll
      for (int j = 0; j < 4; ++j) acc[i][j] = zero16();
    float* rs_s = (float*)(smem + XTRA_OFF);
    const float myrs = (tid < 128) ? rstd_of(P.ssA, m0 + tid) : 0.f;
    gemm_mainloop_w(P.hb0 + (size_t)m0 * 1024, 1024, P.Wt_in + (size_t)n0 * 1024, 1024, 1024, acc, smem);
    if (tid < 128) rs_s[tid] = myrs;
    __syncthreads();
    ushort_t* dst = (nt < 4) ? (P.bufA + n0) : (P.bufB + n0 - 1024);
#pragma unroll
    for (int i = 0; i < 2; ++i)
#pragma unroll
      for (int reg = 0; reg < 16; ++reg) {
        const int rl = wm * 64 + i * 32 + crow(reg, h);
        const float rs = rs_s[rl];
#pragma unroll
        for (int j = 0; j < 4; ++j) {
          const int cl = wn * 128 + j * 32 + r;
          float v = acc[i][j][reg] * rs;
          if (nt < 4) v = gelu_tanh(v);
          dst[(size_t)(m0 + rl) * 1024 + cl] = f2bf(v);
        }
      }
  }
}

template <bool F32RES>
DI void phase_resid_gemm(const ushort_t* __restrict__ A, const ushort_t* __restrict__ Bt, const float* resid_f,
                         const ushort_t* resid_b, ushort_t* hb, float* __restrict__ ss, char* smem) {
  const int tid = otid(), lane = tid & 63, w = tid >> 6, wm = w >> 1, wn = w & 1, r = lane & 31, h = lane >> 5;
  float* red = (float*)(smem + XTRA_OFF + 512);
  const int NT = 4, tiles = (T_ / 128) * NT;
  TILE_LOOP(t, tiles) {
    const int mt = t / NT, nt = t % NT, m0 = mt * 128, n0 = nt * 256;
    f32x16 acc[2][4];
#pragma unroll
    for (int i = 0; i < 2; ++i)
#pragma unroll
      for (int j = 0; j < 4; ++j) acc[i][j] = zero16();
    gemm_mainloop_w(A + (size_t)m0 * 1024, 1024, Bt + (size_t)n0 * 1024, 1024, 1024, acc, smem);
#pragma unroll
    for (int i = 0; i < 2; ++i)
#pragma unroll
      for (int reg = 0; reg < 16; ++reg) {
        const int rl = wm * 64 + i * 32 + crow(reg, h);
        const unsigned off = (unsigned)(m0 + rl) * 1024u + (unsigned)(n0 + wn * 128 + r);
        ushort_t* bp = hb + off;
        float sq = 0.f;
#pragma unroll
        for (int j = 0; j < 4; ++j) {
          const float v = acc[i][j][reg] + (F32RES ? resid_f[off + j * 32] : bf2f(resid_b[off + j * 32]));
          bp[j * 32] = f2bf(v);
          sq += v * v;
        }
        sq += dpp_x1(sq); sq += dpp_x2(sq); sq += dpp_x4(sq); sq += dpp_x8(sq); sq = swap_add16(sq, sq);
        if (r == 0) red[wn * 128 + rl] = sq;
        if ((reg & 3) == 3) __builtin_amdgcn_sched_barrier(0);
      }
    __syncthreads();
    if (tid < 128) *(float2*)(ss + (size_t)(m0 + tid) * 8 + 2 * nt) = make_float2(red[tid] + red[128 + tid], 0.f);
  }
}

DI void phase_ple(const Params& P, int layer, const ushort_t* __restrict__ hb_in, ushort_t* __restrict__ hb_out,
                  const float* __restrict__ ss_in, float* __restrict__ ss_out, char* smem) {
  const int tid = otid(), lane = tid & 63, w = tid >> 6, wm = w >> 1, wn = w & 1, r = lane & 31, h = lane >> 5;
  float* red = (float*)(smem + XTRA_OFF + 512);
  const ushort_t* Wg = P.Wt_gate + (size_t)layer * 1024 * 1024;
  const ushort_t* Wp = P.Wt_proj + (size_t)layer * 256 * 1024;
  const ushort_t* pb = P.pb + (size_t)layer * T_ * 256;
  const int NT = 8, tiles = (T_ / 128) * NT;
  TILE_LOOP(t, tiles) {
    const int mt = t / NT, nt = t % NT, m0 = mt * 128, n0 = nt * 128;
    f32x16 acc[2][2], acc2[2][2];
    for (int i = 0; i < 2; ++i) for (int j = 0; j < 2; ++j) { acc[i][j] = zero16(); acc2[i][j] = zero16(); }
    float* rs_s = (float*)(smem + XTRA_OFF);
    const float myrs = (tid < 128) ? rstd_of(ss_in, m0 + tid) : 0.f;
    gemm_mainloop(hb_in + (size_t)m0 * 1024, 1024, Wg + (size_t)n0 * 1024, 1024, 1024, acc, smem);
    gemm_mainloop(pb + (size_t)m0 * 256, 256, Wp + (size_t)n0 * 256, 256, 256, acc2, smem);
    if (tid < 128) rs_s[tid] = myrs;
    __syncthreads();
#pragma unroll
    for (int i = 0; i < 2; ++i)
#pragma unroll
      for (int reg = 0; reg < 16; ++reg) {
        const int row = m0 + wm * 64 + i * 32 + crow(reg, h);
        const float rs = rs_s[row - m0];
#pragma unroll
        for (int j = 0; j < 2; ++j) {
          const int col = n0 + wn * 64 + j * 32 + r;
          const float gate = sigmoidf_(acc[i][j][reg] * rs);
          const float v = bf2f(hb_in[(size_t)row * 1024 + col]) + gate * acc2[i][j][reg];
          acc[i][j][reg] = v;
          hb_out[(size_t)row * 1024 + col] = f2bf(v);
        }
      }
    tile_rowsumsq(acc, red, ss_out, m0, nt);
  }
}

DI void phase_kvq(const Params& P, const ushort_t* __restrict__ hb_in, const float* __restrict__ ss_in, char* smem) {
  const int tid = otid(), lane = tid & 63, w = tid >> 6, wm = w >> 1, wn = w & 1, r = lane & 31, h = lane >> 5;
  const int NT = 12, tiles = (T_ / 128) * NT;
  TILE_LOOP(t, tiles) {
    const int mt = t / NT, nt = t % NT, m0 = mt * 128, n0 = nt * 256;
    f32x16 acc[2][4];
#pragma unroll
    for (int i = 0; i < 2; ++i)
#pragma unroll
      for (int j = 0; j < 4; ++j) acc[i][j] = zero16();
    float* rs_s = (float*)(smem + XTRA_OFF);
    const float myrs = (tid < 128) ? rstd_of(ss_in, m0 + tid) : 0.f;
    gemm_mainloop_w(hb_in + (size_t)m0 * 1024, 1024, P.Wt_kvq + (size_t)n0 * 1024, 1024, 1024, acc, smem);
    if (tid < 128) rs_s[tid] = myrs;
    __syncthreads();
    if (nt >= 4 && nt < 8) {
      constexpr int TS = 136;
      ushort_t* sT = (ushort_t*)smem;
#pragma unroll
      for (int i = 0; i < 2; ++i)
#pragma unroll
        for (int q4 = 0; q4 < 4; ++q4) {
          const int sl = wm * 64 + i * 32 + 8 * q4 + 4 * h;
          const float r0 = rs_s[sl], r1 = rs_s[sl + 1], r2 = rs_s[sl + 2], r3 = rs_s[sl + 3];
#pragma unroll
          for (int j = 0; j < 4; ++j) {
            const int d = wn * 128 + j * 32 + r;
            *(uint2*)(sT + d * TS + sl) = make_uint2(pk2(acc[i][j][q4 * 4 + 0] * r0, acc[i][j][q4 * 4 + 1] * r1),
                                                     pk2(acc[i][j][q4 * 4 + 2] * r2, acc[i][j][q4 * 4 + 3] * r3));
          }
        }
      __syncthreads();
      const int bb = m0 >> 11, s0 = m0 & 2047;
#pragma unroll
      for (int it = 0; it < 16; ++it) {
        const int c = tid + 256 * it, d = c >> 4, part = c & 15;
        const int col = n0 - 1024 + d, hh = col >> 6, dd = col & 63;
        const uint4 v = *(const uint4*)(sT + d * TS + part * 8);
        *(uint4*)(P.bufB + ((size_t)((bb * 16 + hh) * 64 + dd)) * 2048 + s0 + part * 8) = v;
      }
    } else {
#pragma unroll
      for (int i = 0; i < 2; ++i)
#pragma unroll
        for (int q4 = 0; q4 < 4; ++q4) {
          const int rowb = m0 + wm * 64 + i * 32 + 8 * q4 + 4 * h;
          float rs[4];
#pragma unroll
          for (int e = 0; e < 4; ++e) rs[e] = rs_s[rowb - m0 + e];
#pragma unroll
          for (int j = 0; j < 4; ++j) {
            const int col = n0 + wn * 128 + j * 32 + r;
            if (nt < 4) {
#pragma unroll
              for (int e = 0; e < 4; ++e) P.bufA[(size_t)(rowb + e) * 1024 + col] = f2bf(acc[i][j][q4 * 4 + e] * rs[e]);
            } else {
#pragma unroll
              for (int e = 0; e < 4; ++e) P.bufC[(size_t)(rowb + e) * 1024 + col - 2048] = f2bf(acc[i][j][q4 * 4 + e] * rs[e] * (0.125f * 1.4426950408889634f));
            }
          }
        }
    }
  }
}

DI void phase_lru(const Params& P, char* smem) {
  constexpr int XS = 136;
  ushort_t* sX = (ushort_t*)smem;
  float* sAa = (float*)(smem + 128 * XS * 2);
  float* sUu = sAa + 128 * 32;
  float* segA = sUu + 128 * 32;
  float* segU = segA + 256;
  float* carry = segU + 256;
  float* cw = carry + 64;
  float* cb = cw + 512;
  const int tid = otid(), lane = tid & 63, w = tid >> 6, r = lane & 31, h = lane >> 5;
  const int items = 16 * 8 * 4;
  for (int item = obid(); item < items; item += gridDim.x) {
    const int bhd = (item & 7) * 16 + (item >> 5), cgp = (item >> 3) & 3;
    const int b = bhd >> 3, hd = bhd & 7;
    __syncthreads();
    for (int idx = tid; idx < 512; idx += NTHR) cw[idx] = P.a_conv_w[(idx >> 7) * 1024 + hd * 128 + (idx & 127)];
    if (tid < 128) cb[tid] = P.a_conv_b[hd * 128 + tid];
    if (tid < 32) carry[tid] = 0.f;
    bf16x8 br[8], bi[8];
#pragma unroll
    for (int kk = 0; kk < 8; ++kk) {
      br[kk] = *(const bf16x8*)(P.Wt_r + (size_t)(hd * 128 + cgp * 32 + r) * 128 + kk * 16 + h * 8);
      bi[kk] = *(const bf16x8*)(P.Wt_i + (size_t)(hd * 128 + cgp * 32 + r) * 128 + kk * 16 + h * 8);
    }
    const int ch = hd * 128 + cgp * 32 + r;
    const float bR = P.a_b_r[ch], bI = P.a_b_i[ch];
    const float nl = -P.a_lambda[ch];
    const float c8 = -8.f * (fmaxf(nl, 0.f) + log1pf(__expf(-fabsf(nl))));
    __syncthreads();
    const int cch = tid & 15;
    uint4 xa0, xa1, xa2, xa3, xa4, xa5, xa6, xb0, xb1, xb2, xb3, xb4, xb5, xb6;
    const ushort_t* xbase = P.bufB + ((size_t)b * S_) * 1024 + hd * 128 + cch * 8;
#define LRU_XLOAD(tt0) { \
      const int ra_ = (tt0) + (tid >> 4) * 4 - 3, rb_ = ra_ + 64; \
      const ushort_t* pa_ = xbase + (ptrdiff_t)ra_ * 1024; const ushort_t* pb_ = xbase + (ptrdiff_t)rb_ * 1024; \
      const uint4 z4_ = make_uint4(0, 0, 0, 0); const bool fz_ = ra_ < 0; \
      xa0 = fz_ ? z4_ : *(const uint4*)(pa_); xa1 = fz_ ? z4_ : *(const uint4*)(pa_ + 1024); xa2 = fz_ ? z4_ : *(const uint4*)(pa_ + 2048); \
      xa3 = *(const uint4*)(pa_ + 3 * 1024); xa4 = *(const uint4*)(pa_ + 4 * 1024); xa5 = *(const uint4*)(pa_ + 5 * 1024); xa6 = *(const uint4*)(pa_ + 6 * 1024); \
      xb0 = *(const uint4*)(pb_); xb1 = *(const uint4*)(pb_ + 1024); xb2 = *(const uint4*)(pb_ + 2048); xb3 = *(const uint4*)(pb_ + 3 * 1024); \
      xb4 = *(const uint4*)(pb_ + 4 * 1024); xb5 = *(const uint4*)(pb_ + 5 * 1024); xb6 = *(const uint4*)(pb_ + 6 * 1024); }
    LRU_XLOAD(0);
    for (int tile = 0; tile < 16; ++tile) {
      const int t0 = tile * 128;
      const int scol = tid & 31, sseg = tid >> 5;
      const size_t gbase = ((size_t)b * S_ + t0 + sseg * 16) * 1024 + hd * 128 + cgp * 32 + scol;
      {
        float wv[4][8], bv[8];
#pragma unroll
        for (int c = 0; c < 8; ++c) { bv[c] = cb[cch * 8 + c];
#pragma unroll
          for (int k = 0; k < 4; ++k) wv[k][c] = cw[k * 128 + cch * 8 + c]; }
#define CONV_TAP(k, q) a[0] += wv[k][0] * bf_lo(q.x); a[1] += wv[k][1] * bf_hi(q.x); a[2] += wv[k][2] * bf_lo(q.y); a[3] += wv[k][3] * bf_hi(q.y); \
          a[4] += wv[k][4] * bf_lo(q.z); a[5] += wv[k][5] * bf_hi(q.z); a[6] += wv[k][6] * bf_lo(q.w); a[7] += wv[k][7] * bf_hi(q.w);
#define CONV_ROW(rowl, q0, q1, q2, q3) { float a[8]; \
          _Pragma("unroll") for (int c = 0; c < 8; ++c) a[c] = bv[c]; \
          CONV_TAP(0, q0) CONV_TAP(1, q1) CONV_TAP(2, q2) CONV_TAP(3, q3) \
          *(uint4*)(sX + (rowl) * XS + cch * 8) = make_uint4(pk2(a[0], a[1]), pk2(a[2], a[3]), pk2(a[4], a[5]), pk2(a[6], a[7])); }
        const int r0 = (tid >> 4) * 4;
        CONV_ROW(r0 + 0, xa0, xa1, xa2, xa3) CONV_ROW(r0 + 1, xa1, xa2, xa3, xa4) CONV_ROW(r0 + 2, xa2, xa3, xa4, xa5) CONV_ROW(r0 + 3, xa3, xa4, xa5, xa6)
        CONV_ROW(r0 + 64, xb0, xb1, xb2, xb3) CONV_ROW(r0 + 65, xb1, xb2, xb3, xb4) CONV_ROW(r0 + 66, xb2, xb3, xb4, xb5) CONV_ROW(r0 + 67, xb3, xb4, xb5, xb6)
#undef CONV_ROW
#undef CONV_TAP
      }
      __syncthreads();
      LRU_XLOAD((tile < 15 ? tile + 1 : 15) * 128);
      ushort_t yv[16];
#pragma unroll
      for (int i = 0; i < 16; ++i) yv[i] = P.bufA[gbase + (size_t)i * 1024];
      __builtin_amdgcn_sched_barrier(0);
      f32x16 accr = zero16(), acci = zero16();
#pragma unroll
      for (int kk = 0; kk < 8; ++kk) {
        const bf16x8 a = *(const bf16x8*)(sX + (w * 32 + r) * XS + kk * 16 + h * 8);
        accr = mfma32(a, br[kk], accr);
        acci = mfma32(a, bi[kk], acci);
      }
#pragma unroll
      for (int reg = 0; reg < 16; ++reg) {
        const int row = w * 32 + crow(reg, h);
        const float xcv = bf2f(sX[row * XS + cgp * 32 + r]);
        const float rr = sigmoidf_(accr[reg] + bR), ii = sigmoidf_(acci[reg] + bI);
        const float la = c8 * rr;
        const float a = __expf(la);
        const float u = sqrtf(fmaxf(1.f - __expf(2.f * la), 0.f)) * ii * xcv;
        sAa[row * 32 + r] = a; sUu[row * 32 + r] = u;
      }
      __syncthreads();
      {
        const int col = scol, seg = sseg;
        float Aa = 1.f, Uu = 0.f;
#pragma unroll
        for (int i = 0; i < 16; ++i) { const float a = sAa[(seg * 16 + i) * 32 + col], u = sUu[(seg * 16 + i) * 32 + col]; Uu = a * Uu + u; Aa *= a; }
        segA[seg * 32 + col] = Aa; segU[seg * 32 + col] = Uu;
        __syncthreads();
        float hin = carry[(tile & 1) * 32 + col];
        for (int s2 = 0; s2 < seg; ++s2) hin = segA[s2 * 32 + col] * hin + segU[s2 * 32 + col];
#pragma unroll
        for (int i = 0; i < 16; ++i) {
          const float a = sAa[(seg * 16 + i) * 32 + col], u = sUu[(seg * 16 + i) * 32 + col];
          hin = a * hin + u;
          P.bufC[gbase + (size_t)i * 1024] = f2bf(bf2f(yv[i]) * hin);
        }
        if (seg == 7) carry[((tile + 1) & 1) * 32 + col] = hin;
      }
    }
#undef LRU_XLOAD
  }
}

template <bool MASK>
DI void sb_subtile(const f32x16& sreg, float& prun, f32x16& aout, int key0, int qidx, int h) {
  float bt[16], om[16];
#pragma unroll
  for (int i = 0; i < 16; ++i) {
    const float z = fmaxf(sreg[i], -115.f);
    const float e = __builtin_amdgcn_exp2f(-z);
    float bb = __builtin_amdgcn_rcpf(1.f + e);
    float oo = e * bb;
    if (MASK) { const bool ok = (key0 + crow(i, h)) < qidx; bb = ok ? bb : 0.f; oo = ok ? oo : 1.f; }
    bt[i] = bb; om[i] = oo;
  }
  float G[4], Gp[4];
#pragma unroll
  for (int g = 0; g < 4; ++g) { G[g] = (om[4 * g] * om[4 * g + 1]) * (om[4 * g + 2] * om[4 * g + 3]); Gp[g] = plx32(G[g], h != 0); }
  float E[4];
  float run = prun;
#pragma unroll
  for (int g = 3; g >= 0; --g) {
    const float ghi = h ? G[g] : Gp[g];
    const float glo = h ? Gp[g] : G[g];
    const float e_hi = run;
    run *= ghi;
    const float e_lo = run;
    run *= glo;
    E[g] = h ? e_hi : e_lo;
  }
  prun = run;
#pragma unroll
  for (int g = 0; g < 4; ++g) {
    float s = E[g];
    aout[4 * g + 3] = bt[4 * g + 3] * s; s *= om[4 * g + 3];
    aout[4 * g + 2] = bt[4 * g + 2] * s; s *= om[4 * g + 2];
    aout[4 * g + 1] = bt[4 * g + 1] * s; s *= om[4 * g + 1];
    aout[4 * g + 0] = bt[4 * g + 0] * s;
  }
}

DI void phase_attn(const Params& P, char* smem) {
  constexpr int KS = 72;
  ushort_t* sK = (ushort_t*)smem;
  ushort_t* sV = sK + 64 * KS;
  const int tid = otid(), lane = tid & 63, w = tid >> 6, r = lane & 31, h = lane >> 5;
  const int items = 16 * 256;
  for (int item = obid(); item < items; item += gridDim.x) {
    const int slot = item >> 8, wi = slot & 3;
    const int qt = 15 - 4 * (slot >> 2) - (wi == 0 ? 0 : wi == 1 ? 1 : wi == 2 ? 3 : 2);
    const int bh = item & 255, b = bh >> 4, hh = bh & 15;
    const int q0 = qt * 128, qw0 = q0 + w * 32, qidx = qw0 + r;
    ushort_t* qptr = P.bufC + ((size_t)b * S_ + qidx) * 1024 + hh * 64;
    bf16x8 qf[4];
#pragma unroll
    for (int kk = 0; kk < 4; ++kk) qf[kk] = *(const bf16x8*)(qptr + kk * 16 + h * 8);
    f32x16 o0 = zero16(), o1 = zero16();
    float prun = 1.f;
    const int lrow = tid >> 3, lcol = (tid & 7) * 8;
    const ushort_t* kbase = P.bufA + ((size_t)b * S_) * 1024 + hh * 64;
    const ushort_t* vbase = P.bufB + ((size_t)(b * 16 + hh) * 64) * 2048;
    const int ktmax = 2 * qt + 1;
    uint4 rk0, rk1, rv0, rv1;
    rk0 = *(const uint4*)(kbase + (size_t)(ktmax * 64 + lrow) * 1024 + lcol);
    rk1 = *(const uint4*)(kbase + (size_t)(ktmax * 64 + lrow + 32) * 1024 + lcol);
    rv0 = *(const uint4*)(vbase + (size_t)(lrow) * 2048 + ktmax * 64 + lcol);
    rv1 = *(const uint4*)(vbase + (size_t)(lrow + 32) * 2048 + ktmax * 64 + lcol);
    volatile int* dflag = (volatile int*)(smem + 2 * 64 * KS * 2);
    bool wdone = false;
    if (tid < 4) dflag[tid] = 0;
    for (int kt = ktmax; kt >= 0; --kt) {
      __syncthreads();
      if ((dflag[0] & dflag[1] & dflag[2] & dflag[3]) != 0) break;
      *(uint4*)(sK + (lrow) * KS + lcol) = rk0; *(uint4*)(sK + (lrow + 32) * KS + lcol) = rk1;
      *(uint4*)(sV + (lrow) * KS + lcol) = rv0; *(uint4*)(sV + (lrow + 32) * KS + lcol) = rv1;
      __syncthreads();
      if (kt > 0) {
        rk0 = *(const uint4*)(kbase + (size_t)((kt - 1) * 64 + lrow) * 1024 + lcol);
        rk1 = *(const uint4*)(kbase + (size_t)((kt - 1) * 64 + lrow + 32) * 1024 + lcol);
        rv0 = *(const uint4*)(vbase + (size_t)(lrow) * 2048 + (kt - 1) * 64 + lcol);
        rv1 = *(const uint4*)(vbase + (size_t)(lrow + 32) * 2048 + (kt - 1) * 64 + lcol);
      }
      if (kt * 64 <= qw0 + 30 && !wdone) {
        const bool need_mask = (kt * 64 + 63 >= qw0);
#pragma unroll
        for (int sub = 1; sub >= 0; --sub) {
          f32x16 s = zero16();
#pragma unroll
          for (int kk = 0; kk < 4; ++kk) {
            const bf16x8 kf = *(const bf16x8*)(sK + (sub * 32 + r) * KS + kk * 16 + h * 8);
            s = mfma32(kf, qf[kk], s);
          }
          f32x16 a;
          if (need_mask) sb_subtile<true>(s, prun, a, kt * 64 + sub * 32, qidx, h);
          else sb_subtile<false>(s, prun, a, kt * 64 + sub * 32, qidx, h);
#pragma unroll
          for (int st = 0; st < 2; ++st) {
            bf16x8 pf;
            {
              const unsigned p0 = pk2(a[8 * st + 0], a[8 * st + 1]), p1 = pk2(a[8 * st + 2], a[8 * st + 3]);
              const unsigned p2 = pk2(a[8 * st + 4], a[8 * st + 5]), p3 = pk2(a[8 * st + 6], a[8 * st + 7]);
              uint4 pq = make_uint4(p0, p1, p2, p3);
              pf = __builtin_bit_cast(bf16x8, pq);
            }
#pragma unroll
            for (int dt = 0; dt < 2; ++dt) {
              const ushort_t* vp = sV + (dt * 32 + r) * KS + sub * 32 + 16 * st + 4 * h;
              const uint2 v0 = *(const uint2*)vp, v1 = *(const uint2*)(vp + 8);
              uint4 vq = make_uint4(v0.x, v0.y, v1.x, v1.y);
              const bf16x8 vf = __builtin_bit_cast(bf16x8, vq);
              if (dt == 0) o0 = mfma32(vf, pf, o0); else o1 = mfma32(vf, pf, o1);
            }
          }
        }
      }
      if (!wdone && __all((int)(prun < 1e-30f))) { wdone = true; if (lane == 0) dflag[w] = 1; }
    }
    __syncthreads();
#pragma unroll
    for (int g = 0; g < 4; ++g) {
      *(uint2*)(qptr + 8 * g + 4 * h) = make_uint2(pk2(o0[4 * g], o0[4 * g + 1]), pk2(o0[4 * g + 2], o0[4 * g + 3]));
      *(uint2*)(qptr + 32 + 8 * g + 4 * h) = make_uint2(pk2(o1[4 * g], o1[4 * g + 1]), pk2(o1[4 * g + 2], o1[4 * g + 3]));
    }
  }
}

DI void ins16(float (&L)[16], float x) {
#pragma unroll
  for (int i = 0; i < 16; ++i) { const float hi = fmaxf(L[i], x); x = fminf(L[i], x); L[i] = hi; }
}

DI void merge16(float (&L)[16], const float (&O)[16]) {
#pragma unroll
  for (int i = 0; i < 16; ++i) L[i] = fmaxf(L[i], O[15 - i]);
#pragma unroll
  for (int st = 8; st >= 1; st >>= 1)
#pragma unroll
    for (int i = 0; i < 16; ++i)
      if ((i & st) == 0) { const float a = L[i], b = L[i + st]; L[i] = fmaxf(a, b); L[i + st] = fminf(a, b); }
}

DI void sort16(float (&v)[16]) {
#pragma unroll
  for (int k = 2; k <= 16; k <<= 1)
#pragma unroll
    for (int j = k >> 1; j > 0; j >>= 1)
#pragma unroll
      for (int i = 0; i < 16; ++i) {
        const int l = i ^ j;
        if (l > i) {
          const bool desc = ((i & k) == 0);
          const float a = v[i], b = v[l];
          const float mx = fmaxf(a, b), mn = fminf(a, b);
          v[i] = desc ? mx : mn; v[l] = desc ? mn : mx;
        }
      }
}

DI void phase_route(const Params& P, int layer, const ushort_t* __restrict__ hb_in, const float* __restrict__ ss_in, char* smem) {
  constexpr int QS = 136, SS = 129;
  ushort_t* sQ = (ushort_t*)(smem + GEMM_BUF);
  float* sS = (float*)smem;
  const int tid = otid(), lane = tid & 63, w = tid >> 6, wm = w >> 1, wn = w & 1, r = lane & 31, h = lane >> 5;
  const ushort_t* Wq = P.Wt_pq + (size_t)layer * 2048 * 1024;
  const ushort_t* SKl = P.SK + (size_t)layer * 8 * 2 * 128 * 128;
  const int items = (T_ / 128) * 8;
  TILE_LOOP(item, items) {
    const int mt = item >> 3, hd = item & 7, m0 = mt * 128;
    const int trow = (tid & 31) + 32 * (tid >> 6), half = (tid >> 5) & 1;
    float L0[16], L1[16];
#pragma unroll
    for (int p = 0; p < 2; ++p) {
      f32x16 acc[2][2]; for (int i = 0; i < 2; ++i) for (int j = 0; j < 2; ++j) acc[i][j] = zero16();
      gemm_mainloop(hb_in + (size_t)m0 * 1024, 1024, Wq + (size_t)(hd * 256 + p * 128) * 1024, 1024, 1024, acc, smem);
      EPI_LOOP(i, j, reg) {
        const int row = wm * 64 + i * 32 + crow(reg, h), col = wn * 64 + j * 32 + r;
        sQ[row * QS + col] = f2bf(acc[i][j][reg]);
      }
      __syncthreads();
      for (int i = 0; i < 2; ++i) for (int j = 0; j < 2; ++j) acc[i][j] = zero16();
      const ushort_t* skp = SKl + (size_t)((hd * 2 + p) * 128) * 128;
#pragma unroll
      for (int kk = 0; kk < 8; ++kk) {
        const bf16x8 a0 = *(const bf16x8*)(sQ + (wm * 64 + r) * QS + kk * 16 + h * 8);
        const bf16x8 a1 = *(const bf16x8*)(sQ + (wm * 64 + 32 + r) * QS + kk * 16 + h * 8);
        const bf16x8 b0 = *(const bf16x8*)(skp + (size_t)(wn * 64 + r) * 128 + kk * 16 + h * 8);
        const bf16x8 b1 = *(const bf16x8*)(skp + (size_t)(wn * 64 + 32 + r) * 128 + kk * 16 + h * 8);
        acc[0][0] = mfma32(a0, b0, acc[0][0]); acc[0][1] = mfma32(a0, b1, acc[0][1]);
        acc[1][0] = mfma32(a1, b0, acc[1][0]); acc[1][1] = mfma32(a1, b1, acc[1][1]);
      }
      __syncthreads();
      EPI_LOOP(i, j, reg) {
        const int row = wm * 64 + i * 32 + crow(reg, h), col = wn * 64 + j * 32 + r;
        sS[row * SS + col] = acc[i][j][reg];
      }
      __syncthreads();
      float L[16];
#pragma unroll 1
      for (int blk = 0; blk < 4; ++blk) {
        float Sv[16];
#pragma unroll
        for (int c = 0; c < 16; ++c) {
          const int n = half * 64 + blk * 16 + c;
          const float v = sS[trow * SS + n];
          Sv[c] = __uint_as_float((__float_as_uint(v) & ~0x7Fu) | (unsigned)(127 - n));
        }
        sort16(Sv);
        if (blk == 0) {
#pragma unroll
          for (int i = 0; i < 16; ++i) L[i] = Sv[i];
        } else merge16(L, Sv);
      }
      float O[16];
#pragma unroll
      for (int i = 0; i < 16; ++i) O[i] = plx32(L[i], half != 0);
      merge16(L, O);
#pragma unroll
      for (int i = 0; i < 16; ++i) { if (p == 0) L0[i] = L[i]; else L1[i] = L[i]; }
      __syncthreads();
    }
    float F[16];
#pragma unroll
    for (int j = 0; j < 16; ++j) F[j] = __uint_as_float((__float_as_uint(L0[0] + L1[j]) & ~0xFFu) | (unsigned)(255 - j));
#pragma unroll
    for (int i = 1; i < 16; ++i)
#pragma unroll
      for (int j = 0; j < 16; ++j)
        if ((i + 1) * (j + 1) <= 16) {
          const float c = L0[i] + L1[j];
          ins16(F, __uint_as_float((__float_as_uint(c) & ~0xFFu) | (unsigned)(255 - (i * 16 + j))));
        }
    float* slot = sS + tid * 33;
#pragma unroll
    for (int i = 0; i < 16; ++i) { slot[i] = L0[i]; slot[16 + i] = L1[i]; }
    const float rs = rstd_of(ss_in, m0 + trow);
    float ex[16], sum = 0.f;
#pragma unroll
    for (int k = 0; k < 16; ++k) { ex[k] = __expf((F[k] - F[0]) * rs); sum += ex[k]; }
    const float inv = 1.f / sum;
    if (half == 0) {
      unsigned ei[16];
#pragma unroll
      for (int k = 0; k < 16; ++k) {
        const unsigned ci = 255u - (__float_as_uint(F[k]) & 0xFFu);
        const unsigned i1 = 127u - (__float_as_uint(slot[ci >> 4]) & 0x7Fu);
        const unsigned i2 = 127u - (__float_as_uint(slot[16 + (ci & 15)]) & 0x7Fu);
        ei[k] = i1 * 128u + i2;
      }
      ushort_t* ep = P.eidx + (size_t)(m0 + trow) * 128 + hd * 16;
      *(uint4*)ep = make_uint4(ei[0] | (ei[1] << 16), ei[2] | (ei[3] << 16), ei[4] | (ei[5] << 16), ei[6] | (ei[7] << 16));
      *(uint4*)(ep + 8) = make_uint4(ei[8] | (ei[9] << 16), ei[10] | (ei[11] << 16), ei[12] | (ei[13] << 16), ei[14] | (ei[15] << 16));
      ushort_t* gp = (ushort_t*)P.gw + (size_t)(m0 + trow) * 128 + hd * 16;
      *(uint4*)gp = make_uint4(pk2(ex[0] * inv, ex[1] * inv), pk2(ex[2] * inv, ex[3] * inv), pk2(ex[4] * inv, ex[5] * inv), pk2(ex[6] * inv, ex[7] * inv));
      *(uint4*)(gp + 8) = make_uint4(pk2(ex[8] * inv, ex[9] * inv), pk2(ex[10] * inv, ex[11] * inv), pk2(ex[12] * inv, ex[13] * inv), pk2(ex[14] * inv, ex[15] * inv));
    }
    __syncthreads();
  }
}

DI void phase_expert_u(const Params& P, int layer, const ushort_t* __restrict__ hb, ushort_t* __restrict__ P8) {
  const int tid = otid(), lane = tid & 63, w = tid >> 6, b = obid();
  const int part = b & 7, wv = (b >> 3) * 4 + w, nwv = (gridDim.x >> 3) * 4;
  const int pg = lane >> 3, cl = lane & 7;
  const bool b0 = lane & 1, b1 = lane & 2, b2 = lane & 4;
  const unsigned char* Ub = P.Ub8 + (size_t)layer * 16384 * 1024 + part * 128 + cl * 16;
  ushort_t* pout = P8 + (size_t)part * T_ * 128;
  const int it0 = (b2 ? 2 : 0) + (b1 ? 4 : 0) + (b0 ? 8 : 0);
  int ne_lo, ne_hi; uint4 nxa, nxb;
#define U_LOADTOK(tt) { ne_lo = P.eidx[(size_t)(tt) * 128 + lane]; ne_hi = P.eidx[(size_t)(tt) * 128 + 64 + lane]; \
    nxa = *(const uint4*)(hb + (size_t)(tt) * 1024 + part * 128 + cl * 16); nxb = *(const uint4*)(hb + (size_t)(tt) * 1024 + part * 128 + cl * 16 + 8); }
  int t = wv;
  if (t < T_) U_LOADTOK(t);
  for (; t < T_; t += nwv) {
    const int e_lo = ne_lo, e_hi = ne_hi; const uint4 xa = nxa, xb = nxb;
    if (t + nwv < T_) U_LOADTOK(t + nwv);
    __builtin_amdgcn_sched_barrier(0);
    f32x2 x2[8];
    x2[0] = f32x2{bf_lo(xa.x), bf_hi(xa.x)}; x2[1] = f32x2{bf_lo(xa.y), bf_hi(xa.y)}; x2[2] = f32x2{bf_lo(xa.z), bf_hi(xa.z)}; x2[3] = f32x2{bf_lo(xa.w), bf_hi(xa.w)};
    x2[4] = f32x2{bf_lo(xb.x), bf_hi(xb.x)}; x2[5] = f32x2{bf_lo(xb.y), bf_hi(xb.y)}; x2[6] = f32x2{bf_lo(xb.z), bf_hi(xb.z)}; x2[7] = f32x2{bf_lo(xb.w), bf_hi(xb.w)};
    uint4 row[16];
#pragma unroll
    for (int i = 0; i < 16; ++i) {
      const int src = (8 * i + pg) & 63;
      const int e = __shfl(i < 8 ? e_lo : e_hi, src);
      row[i] = *(const uint4*)(Ub + (size_t)e * 1024);
    }
    float p[16];
#pragma unroll
    for (int i = 0; i < 16; ++i) {
      const uint4 rw = row[i];
      f32x2 a = {0.f, 0.f};
      a += __builtin_amdgcn_cvt_pk_f32_fp8((int)rw.x, false) * x2[0]; a += __builtin_amdgcn_cvt_pk_f32_fp8((int)rw.x, true) * x2[1];
      a += __builtin_amdgcn_cvt_pk_f32_fp8((int)rw.y, false) * x2[2]; a += __builtin_amdgcn_cvt_pk_f32_fp8((int)rw.y, true) * x2[3];
      a += __builtin_amdgcn_cvt_pk_f32_fp8((int)rw.z, false) * x2[4]; a += __builtin_amdgcn_cvt_pk_f32_fp8((int)rw.z, true) * x2[5];
      a += __builtin_amdgcn_cvt_pk_f32_fp8((int)rw.w, false) * x2[6]; a += __builtin_amdgcn_cvt_pk_f32_fp8((int)rw.w, true) * x2[7];
      p[i] = a.x + a.y;
    }
    float r8[8], r4[4], r2[2];
#pragma unroll
    for (int i = 0; i < 8; ++i) r8[i] = (b0 ? p[i + 8] : p[i]) + dpp_x1(b0 ? p[i] : p[i + 8]);
#pragma unroll
    for (int i = 0; i < 4; ++i) r4[i] = (b1 ? r8[i + 4] : r8[i]) + dpp_x2(b1 ? r8[i] : r8[i + 4]);
#pragma unroll
    for (int i = 0; i < 2; ++i) r2[i] = (b2 ? r4[i + 2] : r4[i]) + dpp_x4(b2 ? r4[i] : r4[i + 2]);
    ushort_t* po = pout + (size_t)t * 128 + 8 * it0 + pg;
    po[0] = f2bf(r2[0]); po[8] = f2bf(r2[1]);
  }
#undef U_LOADTOK
}

DI void phase_expert_combine(const Params& P, const ushort_t* __restrict__ P8, ushort_t* __restrict__ wb, const float* __restrict__ ss_in) {
  const size_t n4 = (size_t)T_ * 128 / 4, stride = (size_t)gridDim.x * NTHR;
  for (size_t i = (size_t)obid() * NTHR + otid(); i < n4; i += stride) {
    const int t = (int)(i >> 5);
    float4 sacc = make_float4(0.f, 0.f, 0.f, 0.f);
#pragma unroll
    for (int q = 0; q < 8; ++q) {
      const uint2 v = *(const uint2*)(P8 + (size_t)q * T_ * 128 + i * 4);
      sacc.x += bf_lo(v.x); sacc.y += bf_hi(v.x); sacc.z += bf_lo(v.y); sacc.w += bf_hi(v.y);
    }
    const float rs = rstd_of(ss_in, t) * (1.f / U_SCALE);
    const uint2 gq = *(const uint2*)((const ushort_t*)P.gw + i * 4);
    const float4 g = make_float4(bf_lo(gq.x), bf_hi(gq.x), bf_lo(gq.y), bf_hi(gq.y));
    const float w0 = g.x * gelu_tanh(sacc.x * rs) * (1.f / V_SCALE), w1 = g.y * gelu_tanh(sacc.y * rs) * (1.f / V_SCALE);
    const float w2 = g.z * gelu_tanh(sacc.z * rs) * (1.f / V_SCALE), w3 = g.w * gelu_tanh(sacc.w * rs) * (1.f / V_SCALE);
    *(uint2*)(wb + i * 4) = make_uint2(pk2(w0, w1), pk2(w2, w3));
  }
}

DI void phase_expert_v(const Params& P, int layer, ushort_t* __restrict__ hb, const ushort_t* __restrict__ wb,
                       const float* __restrict__ ss_in, float* __restrict__ ss_out) {
  const int tid = otid(), lane = tid & 63, w = tid >> 6, b = obid();
  const int part = b & 7, wv = (b >> 3) * 4 + w, nwv = (gridDim.x >> 3) * 4;
  const int pg = lane >> 3, cl = lane & 7;
  const bool b5 = lane & 32, b4 = lane & 16, b3 = lane & 8;
  const int col = part * 128 + cl * 16 + (b5 ? 8 : 0) + (b4 ? 4 : 0) + (b3 ? 2 : 0);
  const unsigned char* Vb = P.Vb8 + (size_t)layer * 16384 * 1024 + part * 128 + cl * 16;
  int ne_lo, ne_hi; float ng_lo, ng_hi; unsigned nhp;
#define V_LOADTOK(tt) { ne_lo = P.eidx[(size_t)(tt) * 128 + lane]; ne_hi = P.eidx[(size_t)(tt) * 128 + 64 + lane]; \
    ng_lo = bf2f(wb[(size_t)(tt) * 128 + lane]); ng_hi = bf2f(wb[(size_t)(tt) * 128 + 64 + lane]); \
    nhp = *(const unsigned*)(hb + (size_t)(tt) * 1024 + col); }
  int t = wv;
  if (t < T_) V_LOADTOK(t);
  for (; t < T_; t += nwv) {
    const int e_lo = ne_lo, e_hi = ne_hi; float2 hv = make_float2(bf_lo(nhp), bf_hi(nhp));
    const float w_lo = ng_lo, w_hi = ng_hi;
    if (t + nwv < T_) V_LOADTOK(t + nwv);
    __builtin_amdgcn_sched_barrier(0);
    f32x2 acc[8];
#pragma unroll
    for (int i = 0; i < 8; ++i) acc[i] = f32x2{0.f, 0.f};
    uint4 row[16]; float wg[16];
#pragma unroll
    for (int i = 0; i < 16; ++i) {
      const int src = (8 * i + pg) & 63;
      const int e = __shfl(i < 8 ? e_lo : e_hi, src);
      wg[i] = __shfl(i < 8 ? w_lo : w_hi, src);
      row[i] = *(const uint4*)(Vb + (size_t)e * 1024);
    }
#pragma unroll
    for (int i = 0; i < 16; ++i) {
      const f32x2 w2 = {wg[i], wg[i]};
      acc[0] += __builtin_amdgcn_cvt_pk_f32_fp8((int)row[i].x, false) * w2; acc[1] += __builtin_amdgcn_cvt_pk_f32_fp8((int)row[i].x, true) * w2;
      acc[2] += __builtin_amdgcn_cvt_pk_f32_fp8((int)row[i].y, false) * w2; acc[3] += __builtin_amdgcn_cvt_pk_f32_fp8((int)row[i].y, true) * w2;
      acc[4] += __builtin_amdgcn_cvt_pk_f32_fp8((int)row[i].z, false) * w2; acc[5] += __builtin_amdgcn_cvt_pk_f32_fp8((int)row[i].z, true) * w2;
      acc[6] += __builtin_amdgcn_cvt_pk_f32_fp8((int)row[i].w, false) * w2; acc[7] += __builtin_amdgcn_cvt_pk_f32_fp8((int)row[i].w, true) * w2;
    }
    f32x2 r4[4], r2[2], r1;
#pragma unroll
    for (int i = 0; i < 4; ++i) {
      r4[i] = f32x2{swap_add32(acc[i].x, acc[i + 4].x), swap_add32(acc[i].y, acc[i + 4].y)};
    }
#pragma unroll
    for (int i = 0; i < 2; ++i) {
      r2[i] = f32x2{swap_add16(r4[i].x, r4[i + 2].x), swap_add16(r4[i].y, r4[i + 2].y)};
    }
    {
      const f32x2 keep = b3 ? r2[1] : r2[0], send = b3 ? r2[0] : r2[1];
      r1 = keep + f32x2{dpp_x8(send.x), dpp_x8(send.y)};
    }
    hv.x += r1.x; hv.y += r1.y;
    *(unsigned*)(hb + (size_t)t * 1024 + col) = pk2(hv.x, hv.y);
    float sq = hv.x * hv.x + hv.y * hv.y;
    sq += dpp_x1(sq); sq += dpp_x2(sq); sq += dpp_x4(sq); sq += dpp_x8(sq); sq = swap_add16(sq, sq); sq = swap_add32(sq, sq);
    if (lane == 0) ss_out[(size_t)t * 8 + part] = sq;
  }
#undef V_LOADTOK
}

DI void phase_final(const Params& P, const ushort_t* __restrict__ hb, const float* __restrict__ ss) {
  const size_t n8 = (size_t)T_ * 1024 / 8, stride = (size_t)gridDim.x * NTHR;
  for (size_t i = (size_t)obid() * NTHR + otid(); i < n8; i += stride) {
    const int row = (int)(i >> 7), c = (int)(i & 127) * 8;
    const float rs = rstd_of(ss, row);
    const uint4 u = *(const uint4*)(hb + i * 8);
    const float4 g0 = *(const float4*)(P.final_norm + c), g1 = *(const float4*)(P.final_norm + c + 4);
    *(float4*)(P.h + i * 8) = make_float4(bf_lo(u.x) * rs * g0.x, bf_hi(u.x) * rs * g0.y, bf_lo(u.y) * rs * g0.z, bf_hi(u.y) * rs * g0.w);
    *(float4*)(P.h + i * 8 + 4) = make_float4(bf_lo(u.z) * rs * g1.x, bf_hi(u.z) * rs * g1.y, bf_lo(u.w) * rs * g1.z, bf_hi(u.w) * rs * g1.w);
  }
}

#define XB_TMO      128
#define XB_XCNT(j)  (256  + 64 * (j))
#define XB_XSUB(j)  (1280 + 64 * (j))
#define XB_XGEN(j)  (2304 + 64 * (j))
#define XB_TOP      3328
#define XB_TOPGEN   3392
#define XCD_BAR_WORDS 3456
#define XB_SPIN_CAP (1u << 22)
#define LAS __attribute__((address_space(3)))
DI unsigned xb_ld(unsigned* p) { return __hip_atomic_load(p, __ATOMIC_RELAXED, __HIP_MEMORY_SCOPE_AGENT); }
DI unsigned xb_add(unsigned* p, unsigned v) { return __hip_atomic_fetch_add(p, v, __ATOMIC_RELAXED, __HIP_MEMORY_SCOPE_AGENT); }
DI unsigned xb_xcc_id() { return (unsigned)__builtin_amdgcn_s_getreg((3 << 11) | 20) & 0xFu; }
#define XB_SPIN(cond, bar) do { unsigned _sp = 0; while (cond) { __builtin_amdgcn_s_sleep(1); \
    if ((++_sp & 255u) == 0u) { if (xb_ld(&(bar)[XB_TMO])) break; if (_sp > XB_SPIN_CAP) { atomicAdd(&(bar)[XB_TMO], 1u); break; } } } } while (0)
struct XcdBarrier { unsigned* bar; unsigned x; volatile LAS unsigned* st; };
DI XcdBarrier xcd_barrier_post(unsigned* bar, volatile LAS unsigned* st) {
  XcdBarrier b; b.bar = bar; b.x = xb_xcc_id(); b.st = st;
  if (threadIdx.x == 0) (void)xb_add(&bar[XB_XCNT(b.x)], 1u);
  return b;
}
DI void xcd_barrier_complete(unsigned* bar, unsigned x, unsigned& nloc, unsigned& nx) {
  const unsigned G = gridDim.x * gridDim.y * gridDim.z;
  unsigned sum, cnt, mine, sp = 0u;
  for (;;) {
    sum = 0u; cnt = 0u; mine = 0u;
#pragma unroll
    for (unsigned j = 0; j < 16; ++j) { const unsigned c = xb_ld(&bar[XB_XCNT(j)]); sum += c; cnt += (c > 0u) ? 1u : 0u; mine = (j == x) ? c : mine; }
    if (sum == G) break;
    __builtin_amdgcn_s_sleep(1);
    if ((++sp & 255u) == 0u) { if (xb_ld(&bar[XB_TMO])) break; if (sp > XB_SPIN_CAP) { atomicAdd(&bar[XB_TMO], 1u); break; } }
  }
  nloc = mine > 0u ? mine : 1u; nx = cnt > 0u ? cnt : 1u;
}
DI void xcd_barrier(const XcdBarrier& b) {
  asm volatile("s_waitcnt vmcnt(0)" ::: "memory");
  __syncthreads();
  if (threadIdx.x == 0) {
    unsigned* bar = b.bar;
    __builtin_amdgcn_s_waitcnt(0);
    unsigned nloc = b.st[0], nx = b.st[1];
    if (nloc == 0u) { xcd_barrier_complete(bar, b.x, nloc, nx); b.st[0] = nloc; b.st[1] = nx; }
    const unsigned old = xb_add(&bar[XB_XSUB(b.x)], 1u);
    const unsigned gen = old / nloc;
    if (old + 1u == (gen + 1u) * nloc) {
      __builtin_amdgcn_fence(__ATOMIC_RELEASE, "agent");
      asm volatile("s_waitcnt vmcnt(0)" ::: "memory");
      const unsigned og = xb_add(&bar[XB_TOP], 1u);
      const unsigned tg = og / nx;
      if (og + 1u == (tg + 1u) * nx) xb_add(&bar[XB_TOPGEN], 1u);
      else XB_SPIN(xb_ld(&bar[XB_TOPGEN]) == tg, bar);
      __builtin_amdgcn_fence(__ATOMIC_ACQUIRE, "agent");
      xb_add(&bar[XB_XGEN(b.x)], 1u);
      asm volatile("s_waitcnt vmcnt(0)" ::: "memory");
    } else {
      XB_SPIN(xb_ld(&bar[XB_XGEN(b.x)]) == gen, bar);
      __builtin_amdgcn_fence(__ATOMIC_ACQUIRE, "agent");
      asm volatile("s_waitcnt vmcnt(0)" ::: "memory");
    }
  }
  __syncthreads();
}

DI void run_phase(const Params& P, int ph, char* smem) {
  ushort_t* P8 = P.bufA;
  ushort_t* wb = P.bufB;
  switch (ph) {
    case 0: phase_prep(P, smem); break;
    case 1: phase_in(P, smem); break;
    case 2: phase_lru(P, smem); break;
    case 3: phase_resid_gemm<false>(P.bufC, P.Wt_out, nullptr, P.hb0, P.hb0, P.ssA, smem); break;
    case 4: phase_route(P, 0, P.hb0, P.ssA, smem); break;
    case 5: phase_expert_u(P, 0, P.hb0, P8); break;
    case 6: phase_expert_combine(P, P8, wb, P.ssA); break;
    case 7: phase_expert_v(P, 0, P.hb0, wb, P.ssA, P.ssB); break;
    case 8: phase_ple(P, 0, P.hb0, P.hb1, P.ssB, P.ssA, smem); break;
    case 9: phase_kvq(P, P.hb1, P.ssA, smem); break;
    case 10: phase_attn(P, smem); break;
    case 11: phase_resid_gemm<false>(P.bufC, P.Wt_o, nullptr, P.hb1, P.hb1, P.ssB, smem); break;
    case 12: phase_route(P, 1, P.hb1, P.ssB, smem); break;
    case 13: phase_expert_u(P, 1, P.hb1, P8); break;
    case 14: phase_expert_combine(P, P8, wb, P.ssB); break;
    case 15: phase_expert_v(P, 1, P.hb1, wb, P.ssB, P.ssA); break;
    case 16: phase_ple(P, 1, P.hb1, P.hb0, P.ssA, P.ssB, smem); break;
    case 17: phase_final(P, P.hb0, P.ssB); break;
    default: break;
  }
}

#if MEGA
__global__ void __launch_bounds__(NTHR, 2) mega_kernel(Params P) {
  __shared__ __attribute__((aligned(16))) char smem[SMEM_BYTES];
  __shared__ uint4 xb_words;
  if (threadIdx.x == 0) xb_words = make_uint4(0u, 0u, 0u, 0u);
  __syncthreads();
  XcdBarrier xb = xcd_barrier_post(P.bar, (volatile LAS unsigned*)&xb_words);
  if (P.bar == nullptr) cg::this_grid().sync();
#define PH_(n) run_phase(P, n, smem); xcd_barrier(xb);
  PH_(0) PH_(1) PH_(2) PH_(3) PH_(4) PH_(5) PH_(6) PH_(7) PH_(8) PH_(9) PH_(10) PH_(11) PH_(12) PH_(13) PH_(14) PH_(15) PH_(16)
#undef PH_
  run_phase(P, 17, smem);
}
#else
template <int PH>
__global__ void __launch_bounds__(NTHR, 2) phase_kernel(Params P) {
  __shared__ __attribute__((aligned(16))) char smem[SMEM_BYTES];
  run_phase(P, PH, smem);
}
template <int PH> static void launch_phases(const Params& P, hipStream_t stream) {
  phase_kernel<PH><<<512, NTHR, 0, stream>>>(P);
  if constexpr (PH + 1 < 18) launch_phases<PH + 1>(P, stream);
}
#endif

extern "C" void kernel_launch(void* const* d_in, const int* in_sizes, int n_in, void* d_out, int out_size, void* d_ws,
                              size_t ws_size, hipStream_t stream) {
  Params P{};
  const float** fp = (const float**)&P;
  for (int i = 0; i < 25; ++i) fp[i] = (const float*)d_in[i];
  P.h = (float*)d_out;
  char* ws = (char*)d_ws;
  const size_t MB = 1024 * 1024;
  size_t off = 0;
  auto take = [&](size_t bytes) { char* p = ws + off; off += (bytes + 255) & ~(size_t)255; return p; };
  P.Wt_in = (ushort_t*)take(4 * MB); P.Wt_out = (ushort_t*)take(2 * MB); P.Wt_kvq = (ushort_t*)take(6 * MB);
  P.Wt_o = (ushort_t*)take(2 * MB); P.Wt_pq = (ushort_t*)take(8 * MB); P.Wt_gate = (ushort_t*)take(4 * MB);
  P.Wt_proj = (ushort_t*)take(1 * MB); P.Wt_r = (ushort_t*)take(256 * 1024); P.Wt_i = (ushort_t*)take(256 * 1024);
  P.SK = (ushort_t*)take(1 * MB);
  P.Ub8 = (unsigned char*)take(32 * MB); P.Vb8 = (unsigned char*)take(32 * MB); P.pb = (ushort_t*)take(32 * MB);
  P.hb0 = (ushort_t*)take(64 * MB); P.hb1 = (ushort_t*)take(64 * MB);
  P.bufA = (ushort_t*)take(64 * MB); P.bufB = (ushort_t*)take(64 * MB); P.bufC = (ushort_t*)take(64 * MB);
  P.eidx = (ushort_t*)take(8 * MB); P.gw = (float*)take(16 * MB);
  P.ssA = (float*)take(1 * MB); P.ssB = (float*)take(1 * MB);
  P.bar = (unsigned*)take(64 * 1024);
  if (off > ws_size) { fprintf(stderr, "workspace too small: need %zu have %zu\n", off, ws_size); return; }
#if MEGA
  static int grid_blocks = 0;
  if (!grid_blocks) {
    int dev = 0, cus = 0, per_cu = 0;
    hipGetDevice(&dev);
    hipDeviceGetAttribute(&cus, hipDeviceAttributeMultiprocessorCount, dev);
    hipOccupancyMaxActiveBlocksPerMultiprocessor(&per_cu, mega_kernel, NTHR, 0);
    if (per_cu > 2) per_cu = 2;
    if (per_cu < 1) per_cu = 1;
    grid_blocks = cus * per_cu;
  }
  void* args[] = {&P};
  hipMemsetAsync(P.bar, 0, XCD_BAR_WORDS * sizeof(unsigned), stream);
  hipError_t e = hipLaunchCooperativeKernel((void*)mega_kernel, dim3(grid_blocks), dim3(NTHR), args, 0, stream);
  if (e != hipSuccess) fprintf(stderr, "cooperative launch failed: %s (grid %d)\n", hipGetErrorString(e), grid_blocks);
#else
  launch_phases<0>(P, stream);
#endif
}
```
